# Optimizing an MI355X kernel written in HIP

```python
import math
import jax, jax.numpy as jnp
from jax import lax
import numpy as np


D_MODEL = 1024
BATCH = 16
SEQ = 2048
DEPTH = 4

GRID_W = 64
Q_BLOCK = 128
EPS = 1e-6

A_HEADS = 8
A_KV_HEADS = 2
A_GROUP = A_HEADS // A_KV_HEADS
A_HEAD_DIM = 64
AXIAL_THETA = 10000.0

B_HEADS = 8
B_QK_DIM = 32
B_V_DIM = 2 * B_QK_DIM
B_ROT_DIM = B_QK_DIM // 4
ROPE_THETA = 500000.0

C_HEADS = 8
C_Q_RANK = 384
C_KV_RANK = 256
C_NOPE_DIM = 64
C_ROPE_DIM = 32
C_V_DIM = 64
MLA_THETA = 10000.0

N_BRANCH = 3
BRANCH_W = 512
D_FF = 4 * D_MODEL

A_Q_W = A_HEADS * A_HEAD_DIM
A_KV_W = A_KV_HEADS * A_HEAD_DIM
B_QK_W = B_HEADS * 2 * B_QK_DIM
B_V_W = B_HEADS * B_V_DIM
GATE_W = N_BRANCH * D_MODEL
IN_SIZES = (A_Q_W, A_KV_W, A_KV_W, B_QK_W, B_QK_W, B_V_W, C_Q_RANK, C_KV_RANK, C_ROPE_DIM, GATE_W)
IN_COLS = A_Q_W + 2 * A_KV_W + 2 * B_QK_W + B_V_W + C_Q_RANK + C_KV_RANK + C_ROPE_DIM + GATE_W

kernel_name = 'hybrid_gated_gqa_diff_mla_encoder'


def _rms_norm(x, g):
    xf = x.astype(jnp.float32)
    y = xf * lax.rsqrt(jnp.mean(xf * xf, axis=-1, keepdims=True) + EPS)
    return (y * g.astype(jnp.float32)).astype(x.dtype)


def _angles(pos, dim, theta):
    inv_freq = theta ** (-jnp.arange(0, dim, 2, dtype=jnp.float32) / dim)
    return pos.astype(jnp.float32)[:, None] * inv_freq[None, :]


def _rotate(x, ang):
    cos = jnp.cos(ang)[:, None, :].astype(x.dtype)
    sin = jnp.sin(ang)[:, None, :].astype(x.dtype)
    x1, x2 = jnp.split(x, 2, axis=-1)
    return jnp.concatenate([x1 * cos - x2 * sin, x2 * cos + x1 * sin], axis=-1)


def _softmax_f32(s):
    return jax.nn.softmax(s.astype(jnp.float32), axis=-1)


def _sweep_query_blocks(block_fn, *qs):
    b, s = qs[0].shape[:2]
    nb = s // Q_BLOCK
    blocked = tuple(jnp.swapaxes(q.reshape((b, nb, Q_BLOCK) + q.shape[2:]), 0, 1) for q in qs)
    out = lax.map(lambda qb: block_fn(*qb), blocked)
    out = jnp.swapaxes(out, 0, 1)
    return out.reshape((b, s) + out.shape[3:])


def _split_columns(p):
    out, start = [], 0
    for n in IN_SIZES:
        out.append(p[..., start:start + n])
        start += n
    return out


def _gqa_axial(q, k, v, q_g, k_g, row_ang, col_ang):
    b, s = q.shape[:2]
    half = A_HEAD_DIM // 2

    def axial(t):
        return jnp.concatenate([_rotate(t[..., :half], row_ang), _rotate(t[..., half:], col_ang)], axis=-1)

    q = axial(_rms_norm(q, q_g)) * (A_HEAD_DIM ** -0.5)
    k = axial(_rms_norm(k, k_g))
    q = q.reshape(b, s, A_KV_HEADS, A_GROUP, A_HEAD_DIM)

    def block(qb):
        sc = jnp.einsum('bqkgd,bskd->bkgqs', qb, k)
        p = _softmax_f32(sc).astype(v.dtype)
        return jnp.einsum('bkgqs,bskd->bqkgd', p, v)

    o = _sweep_query_blocks(block, q)
    return o.reshape(b, s, A_HEADS * A_HEAD_DIM)


def _diff_attention(q, k, v, lam_p, sub_g, lambda_init, rot_ang):
    b, s = q.shape[:2]

    def partial_rot(t):
        t = t.reshape(b, s, B_HEADS * 2, B_QK_DIM)
        t = jnp.concatenate([_rotate(t[..., :B_ROT_DIM], rot_ang), t[..., B_ROT_DIM:]], axis=-1)
        return t.reshape(b, s, B_HEADS, 2, B_QK_DIM)

    q = partial_rot(q) * (B_QK_DIM ** -0.5)
    k = partial_rot(k)
    v = v.reshape(b, s, B_HEADS, B_V_DIM)
    lf = lam_p.astype(jnp.float32)
    lam = jnp.exp(jnp.sum(lf[0] * lf[1])) - jnp.exp(jnp.sum(lf[2] * lf[3])) + lambda_init

    def block(qb):
        sc = jnp.einsum('bqhcd,bshcd->bhcqs', qb, k)
        p = _softmax_f32(sc)
        p = (p[:, :, 0] - lam * p[:, :, 1]).astype(v.dtype)
        return jnp.einsum('bhqs,bshe->bqhe', p, v)

    o = _sweep_query_blocks(block, q)
    o = _rms_norm(o, sub_g) * (1.0 - lambda_init)
    return o.reshape(b, s, B_HEADS * B_V_DIM)


def _mla(c_q, c_kv, k_r, q_g, kv_g, w_uq, w_ukv, ang):
    b, s = c_q.shape[:2]
    q = jnp.einsum('bsr,rn->bsn', _rms_norm(c_q, q_g), w_uq).reshape(b, s, C_HEADS, C_NOPE_DIM + C_ROPE_DIM)
    kv = jnp.einsum('bsr,rn->bsn', _rms_norm(c_kv, kv_g), w_ukv).reshape(b, s, C_HEADS, C_NOPE_DIM + C_V_DIM)
    scale = (C_NOPE_DIM + C_ROPE_DIM) ** -0.5
    q_nope = q[..., :C_NOPE_DIM] * scale
    q_rope = _rotate(q[..., C_NOPE_DIM:], ang) * scale
    k_nope, v = kv[..., :C_NOPE_DIM], kv[..., C_NOPE_DIM:]
    k_rope = _rotate(k_r[:, :, None, :], ang)[:, :, 0]

    def block(qn, qr):
        sc = jnp.einsum('bqhd,bshd->bhqs', qn, k_nope) + jnp.einsum('bqhr,bsr->bhqs', qr, k_rope)
        p = _softmax_f32(sc).astype(v.dtype)
        return jnp.einsum('bhqs,bshe->bqhe', p, v)

    o = _sweep_query_blocks(block, q_nope, q_rope)
    return o.reshape(b, s, C_HEADS * C_V_DIM)


def setup_inputs(seed: int = 0) -> dict:
    key = jax.random.key(seed)
    ks = jax.random.split(key, 20)
    f32 = jnp.float32

    def nrm(k, shape, scale):
        return jax.random.normal(k, shape, f32) * scale

    def gain(k, shape):
        return 1.0 + 0.02 * jax.random.normal(k, shape, f32)

    return {
        'x': jax.random.normal(ks[0], (BATCH, SEQ, D_MODEL), f32),
        'ln1_g': gain(ks[1], (DEPTH, D_MODEL)),
        'w_in': nrm(ks[2], (DEPTH, D_MODEL, IN_COLS), D_MODEL ** -0.5),
        'a_q_norm': gain(ks[3], (DEPTH, A_HEAD_DIM)),
        'a_k_norm': gain(ks[4], (DEPTH, A_HEAD_DIM)),
        'b_lambda': nrm(ks[5], (DEPTH, 4, B_QK_DIM), 0.1),
        'b_subln': gain(ks[6], (DEPTH, B_V_DIM)),
        'c_q_norm': gain(ks[7], (DEPTH, C_Q_RANK)),
        'c_kv_norm': gain(ks[8], (DEPTH, C_KV_RANK)),
        'c_w_uq': nrm(ks[9], (DEPTH, C_Q_RANK, C_HEADS * (C_NOPE_DIM + C_ROPE_DIM)), C_Q_RANK ** -0.5),
        'c_w_ukv': nrm(ks[10], (DEPTH, C_KV_RANK, C_HEADS * (C_NOPE_DIM + C_V_DIM)), C_KV_RANK ** -0.5),
        'w_branch': nrm(ks[11], (DEPTH, N_BRANCH, BRANCH_W, D_MODEL), BRANCH_W ** -0.5),
        'w_out': nrm(ks[12], (DEPTH, D_MODEL, D_MODEL), D_MODEL ** -0.5),
        'ln2_g': gain(ks[13], (DEPTH, D_MODEL)),
        'w_ff1': nrm(ks[14], (DEPTH, D_MODEL, D_FF), D_MODEL ** -0.5),
        'w_ff2': nrm(ks[15], (DEPTH, D_FF, D_MODEL), D_FF ** -0.5),
        'final_g': gain(ks[16], (D_MODEL,)),
    }


def reference(x, ln1_g, w_in, a_q_norm, a_k_norm, b_lambda, b_subln, c_q_norm, c_kv_norm,
              c_w_uq, c_w_ukv, w_branch, w_out, ln2_g, w_ff1, w_ff2, final_g):
    b, s, d = x.shape
    n_rows = s // GRID_W
    t = jnp.arange(s)
    row_idx = jnp.repeat(jnp.arange(n_rows), GRID_W)
    col_idx = jnp.tile(jnp.arange(GRID_W), n_rows)
    half = A_HEAD_DIM // 2
    row_ang = _angles(row_idx, half, AXIAL_THETA)
    col_ang = _angles(col_idx, half, AXIAL_THETA)
    b_ang = _angles(t, B_ROT_DIM, ROPE_THETA)
    c_ang = _angles(t, C_ROPE_DIM, MLA_THETA)

    for l in range(DEPTH):
        h = _rms_norm(x, ln1_g[l])
        proj = jnp.einsum('bsd,dn->bsn', h, w_in[l])
        (a_q, a_k, a_v, b_q, b_k, b_v, c_cq, c_ckv, c_kr, gate_logits) = _split_columns(proj)

        y_a = _gqa_axial(a_q.reshape(b, s, A_HEADS, A_HEAD_DIM),
                         a_k.reshape(b, s, A_KV_HEADS, A_HEAD_DIM),
                         a_v.reshape(b, s, A_KV_HEADS, A_HEAD_DIM),
                         a_q_norm[l], a_k_norm[l], row_ang, col_ang)
        lambda_init = 0.8 - 0.6 * math.exp(-0.3 * l)
        y_b = _diff_attention(b_q, b_k, b_v, b_lambda[l], b_subln[l], lambda_init, b_ang)
        y_c = _mla(c_cq, c_ckv, c_kr, c_q_norm[l], c_kv_norm[l], c_w_uq[l], c_w_ukv[l], c_ang)

        y = jnp.stack([y_a, y_b, y_c], axis=2)
        gates = jax.nn.sigmoid(gate_logits.reshape(b, s, N_BRANCH, d))
        merged = jnp.sum(gates * jnp.einsum('bsne,ned->bsnd', y, w_branch[l]), axis=2)
        x = x + jnp.einsum('bsd,de->bse', merged, w_out[l])

        h2 = _rms_norm(x, ln2_g[l])
        ff = jnp.square(jax.nn.relu(jnp.einsum('bsd,df->bsf', h2, w_ff1[l])))
        x = x + jnp.einsum('bsf,fd->bsd', ff, w_ff2[l])

    return _rms_norm(x, final_g)
```

```cpp
#include <hip/hip_runtime.h>
#include <hip/hip_cooperative_groups.h>
#include <cstdio>
namespace cg = cooperative_groups;

#define DI __device__ __forceinline__
typedef unsigned short bf16_t;
typedef __attribute__((ext_vector_type(8))) short bf16x8;
typedef __attribute__((ext_vector_type(4))) short s16x4;
typedef __attribute__((ext_vector_type(16))) float f32x16;
#define MFMA(a, b, c) __builtin_amdgcn_mfma_f32_32x32x16_bf16((a), (b), (c), 0, 0, 0)

constexpr int NT = 32768;
constexpr int SEQ = 2048;
constexpr int DM = 1024;
constexpr int INC = 6048;
constexpr int NP1 = 2976;
constexpr int DEPTH = 4;
constexpr float LOG2E = 1.4426950408889634f;
constexpr float EPS = 1e-6f;

constexpr size_t SZ_T = (size_t)NT * 2;
constexpr size_t OFF_QA = 0;
constexpr size_t OFF_KA = OFF_QA + SZ_T * 512;
constexpr size_t OFF_VAT = OFF_KA + SZ_T * 128;
constexpr size_t OFF_QB = OFF_VAT + SZ_T * 128;
constexpr size_t OFF_KB = OFF_QB + SZ_T * 512;
constexpr size_t OFF_VBT = OFF_KB + SZ_T * 512;
constexpr size_t OFF_QCN = OFF_VBT + SZ_T * 512;
constexpr size_t OFF_QCR = OFF_QCN + SZ_T * 512;
constexpr size_t OFF_KCN = OFF_QCR + SZ_T * 256;
constexpr size_t OFF_KR = OFF_KCN + SZ_T * 512;
constexpr size_t OFF_VCT = OFF_KR + SZ_T * 32;
constexpr size_t OFF_H = OFF_VCT + SZ_T * 512;
constexpr size_t OFF_T2 = OFF_H + SZ_T * 1024;
constexpr size_t OFF_WP1 = OFF_T2 + SZ_T * 2048;
constexpr size_t OFF_WUQ = OFF_WP1 + (size_t)3072 * 1024 * 2;
constexpr size_t OFF_WUKV = OFF_WUQ + (size_t)768 * 384 * 2;
constexpr size_t OFF_WG = OFF_WUKV + (size_t)1024 * 256 * 2;
constexpr size_t OFF_WB = OFF_WG + (size_t)3072 * 1024 * 2;
constexpr size_t OFF_WO = OFF_WB + (size_t)3 * 1024 * 512 * 2;
constexpr size_t OFF_W1 = OFF_WO + (size_t)1024 * 1024 * 2;
constexpr size_t OFF_W2 = OFF_W1 + (size_t)4096 * 1024 * 2;
constexpr size_t OFF_TABC = OFF_W2 + (size_t)4096 * 1024 * 2;
constexpr size_t OFF_TABB = OFF_TABC + (size_t)2048 * 16 * 8;
constexpr size_t OFF_LAM = OFF_TABB + (size_t)2048 * 4 * 8;
constexpr size_t WS_END = OFF_LAM + 64;

constexpr int STG_A = 128 * 128;
constexpr int STG_B = 256 * 128;
constexpr int STG = STG_A + STG_B;
constexpr int NSTG = 3;
constexpr int LDS_GEMM_BYTES = NSTG * STG;
constexpr int LDS_RSTD_OFF = LDS_GEMM_BYTES;
constexpr int LDS_SSQ_OFF = LDS_GEMM_BYTES + 1024;
constexpr int LDS_BYTES = LDS_GEMM_BYTES + 1024 + 5120;
constexpr int KST = 64 * 104;
constexpr int VROW = 72;
constexpr int VST = 64 * VROW;
constexpr int AT_STAGE = KST + VST;
#define WAIT_VM(n) asm volatile("s_waitcnt vmcnt(" #n ")" ::: "memory")
#define RAW_BARRIER() asm volatile("s_waitcnt lgkmcnt(0)\n\ts_barrier" ::: "memory")

struct Params {
  const float* x; const float* ln1_g; const float* w_in; const float* a_q_norm; const float* a_k_norm;
  const float* b_lambda; const float* b_subln; const float* c_q_norm; const float* c_kv_norm;
  const float* c_w_uq; const float* c_w_ukv; const float* w_branch; const float* w_out; const float* ln2_g;
  const float* w_ff1; const float* w_ff2; const float* final_g;
  float* out; unsigned char* ws;
  float lam_init[4];
};

DI unsigned pk2(float a, float b) {
  typedef __attribute__((ext_vector_type(2))) __bf16 bf2;
  bf2 v = {(__bf16)a, (__bf16)b};
  return __builtin_bit_cast(unsigned, v);
}
DI bf16_t f2bf(float a) { return (bf16_t)(pk2(a, 0.f) & 0xffffu); }
DI float bf2f(unsigned v) { return __uint_as_float(v << 16); }
DI float bflo(unsigned v) { return __uint_as_float(v << 16); }
DI float bfhi(unsigned v) { return __uint_as_float(v & 0xffff0000u); }
DI float xh_max(float v) { auto r = __builtin_amdgcn_permlane32_swap(__float_as_uint(v), __float_as_uint(v), false, false); return fmaxf(__uint_as_float(r[0]), __uint_as_float(r[1])); }
DI float xh_sum(float v) { auto r = __builtin_amdgcn_permlane32_swap(__float_as_uint(v), __float_as_uint(v), false, false); return __uint_as_float(r[0]) + __uint_as_float(r[1]); }
DI float xh_other(float v, int h) { auto r = __builtin_amdgcn_permlane32_swap(__float_as_uint(v), __float_as_uint(v), false, false); return __uint_as_float(h ? r[0] : r[1]); }
DI float ex2(float v) { return __builtin_amdgcn_exp2f(v); }
DI int crow(int i, int h) { return (i & 3) + 8 * (i >> 2) + 4 * h; }
DI int otid() { int t = threadIdx.x; asm volatile("" : "+v"(t)); return t; }

DI void store16(bf16_t* dst, const float* o, int h) {
#pragma unroll
  for (int g = 0; g < 4; ++g) {
    uint2 v; v.x = pk2(o[4 * g], o[4 * g + 1]); v.y = pk2(o[4 * g + 2], o[4 * g + 3]);
    *(uint2*)(dst + 8 * g + 4 * h) = v;
  }
}
DI void store16v(bf16_t* dst, const f32x16& o, float sc, int h) {
#pragma unroll
  for (int g = 0; g < 4; ++g) {
    uint2 v; v.x = pk2(o[4 * g] * sc, o[4 * g + 1] * sc); v.y = pk2(o[4 * g + 2] * sc, o[4 * g + 3] * sc);
    *(uint2*)(dst + 8 * g + 4 * h) = v;
  }
}
DI void store16T(bf16_t* dst, const f32x16& o, float sc, int h) {
#pragma unroll
  for (int i = 0; i < 16; ++i) dst[(size_t)crow(i, h) * SEQ] = f2bf(o[i] * sc);
}
DI int vperm(int s) { return (s & ~12) | ((s & 4) << 1) | ((s & 8) >> 1); }

constexpr int EPI_ROWB = 144;
constexpr int EPI_WAVE = 32 * EPI_ROWB;
DI void wave_rows_bf16(unsigned char* lw, const float (&o)[2][16], bf16_t* dst0, int row_stride, int lane) {
  const int r = lane & 31, h = lane >> 5;
#pragma unroll
  for (int nb = 0; nb < 2; ++nb)
#pragma unroll
    for (int g = 0; g < 4; ++g) {
      uint2 v; v.x = pk2(o[nb][4 * g], o[nb][4 * g + 1]); v.y = pk2(o[nb][4 * g + 2], o[nb][4 * g + 3]);
      *(uint2*)(lw + r * EPI_ROWB + (nb * 32 + 8 * g + 4 * h) * 2) = v;
    }
#pragma unroll
  for (int it = 0; it < 4; ++it) {
    const int id = it * 64 + lane, row = id >> 3, c = id & 7;
    const uint4 v = *(const uint4*)(lw + row * EPI_ROWB + c * 16);
    *(uint4*)(dst0 + (size_t)row * row_stride + c * 8) = v;
  }
  asm volatile("" ::: "memory");
}
DI void wave_rows_rmw_f32(unsigned char* lw, const f32x16& a, const float* src0, float* dst0, int lane) {
  const int r = lane & 31, h = lane >> 5;
  float4 xv[4];
#pragma unroll
  for (int it = 0; it < 4; ++it) { const int id = it * 64 + lane; xv[it] = *(const float4*)(src0 + (size_t)(id >> 3) * DM + (id & 7) * 4); }
#pragma unroll
  for (int g = 0; g < 4; ++g) {
    float4 v = {a[4 * g], a[4 * g + 1], a[4 * g + 2], a[4 * g + 3]};
    *(float4*)(lw + r * EPI_ROWB + (8 * g + 4 * h) * 4) = v;
  }
#pragma unroll
  for (int it = 0; it < 4; ++it) {
    const int id = it * 64 + lane, row = id >> 3, c = id & 7;
    const float4 v = *(const float4*)(lw + row * EPI_ROWB + c * 16);
    float4 x = xv[it]; x.x += v.x; x.y += v.y; x.z += v.z; x.w += v.w;
    *(float4*)(dst0 + (size_t)row * DM + c * 4) = x;
  }
  asm volatile("" ::: "memory");
}

typedef _Float16 hf2 __attribute__((ext_vector_type(2)));
DI unsigned pkh2(float a, float b) { hf2 v = {(_Float16)a, (_Float16)b}; return __builtin_bit_cast(unsigned, v); }
DI float hlo(unsigned u) { return (float)__builtin_bit_cast(hf2, u)[0]; }
DI float hhi(unsigned u) { return (float)__builtin_bit_cast(hf2, u)[1]; }
template <int SRCF, int DSTF>
DI void wave_rows_res(unsigned char* lw, const f32x16& a, const void* src0, void* dst0, int dstride, int lane) {
  const int r = lane & 31, h = lane >> 5;
  float4 xv[4];
#pragma unroll
  for (int it = 0; it < 4; ++it) {
    const int id = it * 64 + lane; const size_t off = (size_t)(id >> 3) * DM + (id & 7) * 4;
    if (SRCF) xv[it] = *(const float4*)((const float*)src0 + off);
    else { const uint2 u = *(const uint2*)((const bf16_t*)src0 + off); xv[it] = make_float4(hlo(u.x), hhi(u.x), hlo(u.y), hhi(u.y)); }
  }
#pragma unroll
  for (int g = 0; g < 4; ++g) {
    float4 v = {a[4 * g], a[4 * g + 1], a[4 * g + 2], a[4 * g + 3]};
    *(float4*)(lw + r * EPI_ROWB + (8 * g + 4 * h) * 4) = v;
  }
#pragma unroll
  for (int it = 0; it < 4; ++it) {
    const int id = it * 64 + lane, row = id >> 3, c = id & 7;
    const float4 v = *(const float4*)(lw + row * EPI_ROWB + c * 16);
    float4 x = xv[it]; x.x += v.x; x.y += v.y; x.z += v.z; x.w += v.w;
    if (DSTF) *(float4*)((float*)dst0 + (size_t)row * dstride + c * 4) = x;
    else { uint2 o; o.x = pkh2(x.x, x.y); o.y = pkh2(x.z, x.w); *(uint2*)((bf16_t*)dst0 + (size_t)row * DM + c * 4) = o; }
  }
  asm volatile("" ::: "memory");
}
DI void rmsnorm_tile_b(const bf16_t* x, const float* __restrict__ g, bf16_t* __restrict__ dst) {
  const int tid_ = otid();
  const int lane = tid_ & 63, wave = tid_ >> 6;
  float4 gg[4];
#pragma unroll
  for (int j = 0; j < 4; ++j) gg[j] = *(const float4*)(g + j * 256 + lane * 4);
#pragma unroll 1
  for (int r0 = wave * 16; r0 < wave * 16 + 16; r0 += 8) {
    uint2 u[8][4];
#pragma unroll
    for (int q = 0; q < 8; ++q)
#pragma unroll
      for (int j = 0; j < 4; ++j) u[q][j] = *(const uint2*)(x + (size_t)(r0 + q) * DM + j * 256 + lane * 4);
#pragma unroll
    for (int q = 0; q < 8; ++q) {
      float4 v[4];
      float ss = 0.f;
#pragma unroll
      for (int j = 0; j < 4; ++j) { v[j] = make_float4(hlo(u[q][j].x), hhi(u[q][j].x), hlo(u[q][j].y), hhi(u[q][j].y)); ss += v[j].x * v[j].x + v[j].y * v[j].y + v[j].z * v[j].z + v[j].w * v[j].w; }
#pragma unroll
      for (int o = 32; o >= 1; o >>= 1) ss += __shfl_xor(ss, o);
      const float rs = rsqrtf(ss * (1.f / 1024.f) + EPS);
#pragma unroll
      for (int j = 0; j < 4; ++j) {
        uint2 o2; o2.x = pk2(v[j].x * rs * gg[j].x, v[j].y * rs * gg[j].y); o2.y = pk2(v[j].z * rs * gg[j].z, v[j].w * rs * gg[j].w);
        *(uint2*)(dst + (size_t)(r0 + q) * DM + j * 256 + lane * 4) = o2;
      }
    }
  }
}
DI void final_norm(const unsigned char* segws, const float* __restrict__ g, float* __restrict__ out) {
  const int tid_ = otid();
  const int lane = tid_ & 63, wave = tid_ >> 6;
  const float* sg[4] = {(const float*)(segws + OFF_QA), (const float*)(segws + OFF_QB), (const float*)(segws + OFF_KB), (const float*)(segws + OFF_QCN)};
  float4 gg[4];
#pragma unroll
  for (int j = 0; j < 4; ++j) gg[j] = *(const float4*)(g + j * 256 + lane * 4);
#pragma unroll 1
  for (int r0 = wave * 16; r0 < wave * 16 + 16; r0 += 4) {
    float4 v[4][4];
#pragma unroll
    for (int q = 0; q < 4; ++q)
#pragma unroll
      for (int j = 0; j < 4; ++j) v[q][j] = *(const float4*)(sg[j] + (size_t)(r0 + q) * 256 + lane * 4);
#pragma unroll
    for (int q = 0; q < 4; ++q) {
      float ss = 0.f;
#pragma unroll
      for (int j = 0; j < 4; ++j) ss += v[q][j].x * v[q][j].x + v[q][j].y * v[q][j].y + v[q][j].z * v[q][j].z + v[q][j].w * v[q][j].w;
#pragma unroll
      for (int o = 32; o >= 1; o >>= 1) ss += __shfl_xor(ss, o);
      const float rs = rsqrtf(ss * (1.f / 1024.f) + EPS);
#pragma unroll
      for (int j = 0; j < 4; ++j) {
        float4 o4 = {v[q][j].x * rs * gg[j].x, v[q][j].y * rs * gg[j].y, v[q][j].z * rs * gg[j].z, v[q][j].w * rs * gg[j].w};
        *(float4*)(out + (size_t)(r0 + q) * DM + j * 256 + lane * 4) = o4;
      }
    }
  }
}

DI void convert_T(const float* __restrict__ src, int ld_src, int K, int N, bf16_t* __restrict__ dst, int ld_dst,
                  const float* __restrict__ g, float* ldsf) {
  const int tid = otid();
  const int ntn = (N + 63) >> 6, ntk = K >> 6;
  const int nt = ntn * ntk;
  const int n = tid & 63, kb = tid >> 6;
  float v[8];
  auto load_tile = [&](int t, float (&o)[8]) {
    const int k0 = (t / ntn) * 64, n0 = (t % ntn) * 64;
    const bool ok = (n0 + n) < N;
#pragma unroll
    for (int i = 0; i < 8; ++i) {
      const int k = kb + 8 * i;
      float x = ok ? src[(size_t)(k0 + k) * ld_src + n0 + n] : 0.f;
      if (g) x *= g[k0 + k];
      o[i] = x;
    }
  };
  int t = blockIdx.x;
  const int G_ = gridDim.x;
  float w1[8] = {0.f, 0.f, 0.f, 0.f, 0.f, 0.f, 0.f, 0.f};
  if (t < nt) load_tile(t, v);
  if (t + G_ < nt) load_tile(t + G_, w1);
  for (; t < nt; t += G_) {
    const int k0 = (t / ntn) * 64, n0 = (t % ntn) * 64;
    float nv[8] = {0.f, 0.f, 0.f, 0.f, 0.f, 0.f, 0.f, 0.f};
    const int tn = t + 2 * G_;
    if (tn < nt) load_tile(tn, nv);
    __syncthreads();
#pragma unroll
    for (int i = 0; i < 8; ++i) ldsf[n * 65 + kb + 8 * i] = v[i];
    __syncthreads();
    {
      const int n2 = tid >> 3, c = (tid & 7) * 8;
      if (n0 + n2 < N) {
        const float* sp = ldsf + n2 * 65 + c;
        uint4 o; o.x = pk2(sp[0], sp[1]); o.y = pk2(sp[2], sp[3]); o.z = pk2(sp[4], sp[5]); o.w = pk2(sp[6], sp[7]);
        *(uint4*)(dst + (size_t)(n0 + n2) * ld_dst + k0 + c) = o;
      }
    }
#pragma unroll
    for (int i = 0; i < 8; ++i) { v[i] = w1[i]; w1[i] = nv[i]; }
  }
}

template <bool F32OUT>
DI void rmsnorm_tile(const float* x, const float* __restrict__ g, bf16_t* __restrict__ dst, float* dstf) {
  const int tid_ = otid();
  const int lane = tid_ & 63, wave = tid_ >> 6;
  float4 gg[4];
#pragma unroll
  for (int j = 0; j < 4; ++j) gg[j] = *(const float4*)(g + j * 256 + lane * 4);
#pragma unroll 1
  for (int r0 = wave * 16; r0 < wave * 16 + 16; r0 += 4) {
    float4 v[4][4];
#pragma unroll
    for (int q = 0; q < 4; ++q)
#pragma unroll
      for (int j = 0; j < 4; ++j) v[q][j] = *(const float4*)(x + (size_t)(r0 + q) * DM + j * 256 + lane * 4);
#pragma unroll
    for (int q = 0; q < 4; ++q) {
      float ss = 0.f;
#pragma unroll
      for (int j = 0; j < 4; ++j) ss += v[q][j].x * v[q][j].x + v[q][j].y * v[q][j].y + v[q][j].z * v[q][j].z + v[q][j].w * v[q][j].w;
#pragma unroll
      for (int o = 32; o >= 1; o >>= 1) ss += __shfl_xor(ss, o);
      const float rs = rsqrtf(ss * (1.f / 1024.f) + EPS);
#pragma unroll
      for (int j = 0; j < 4; ++j) {
        const float a = v[q][j].x * rs * gg[j].x, b = v[q][j].y * rs * gg[j].y, c = v[q][j].z * rs * gg[j].z, d = v[q][j].w * rs * gg[j].w;
        if (F32OUT) {
          float4 o4 = {a, b, c, d};
          *(float4*)(dstf + (size_t)(r0 + q) * DM + j * 256 + lane * 4) = o4;
        } else {
          uint2 o2; o2.x = pk2(a, b); o2.y = pk2(c, d);
          *(uint2*)(dst + (size_t)(r0 + q) * DM + j * 256 + lane * 4) = o2;
        }
      }
    }
  }
}

template <class Epi>
DI void gemm_tile(const bf16_t* __restrict__ A, int lda, const bf16_t* __restrict__ Bt, int ldb, int K, bf16_t* lds_, Epi epi) {
  unsigned char* lds = (unsigned char*)lds_;
  const int tid = otid(), lane = tid & 63, wave = tid >> 6;
  const int wm = wave & 1, wn = wave >> 1, r = lane & 31, h = lane >> 5;
  const int lr = lane >> 3, lcp = lane & 7;
  const bf16_t* pa[2]; const bf16_t* pb[4];
#pragma unroll
  for (int i = 0; i < 2; ++i) { const int row = (wave * 2 + i) * 8 + lr; pa[i] = A + (size_t)row * lda + ((lcp ^ ((row >> 1) & 7)) * 8); }
#pragma unroll
  for (int i = 0; i < 4; ++i) { const int row = (wave * 4 + i) * 8 + lr; pb[i] = Bt + (size_t)row * ldb + ((lcp ^ ((row >> 1) & 7)) * 8); }
  f32x16 acc[2][2];
#pragma unroll
  for (int nb = 0; nb < 2; ++nb)
#pragma unroll
    for (int mb = 0; mb < 2; ++mb)
#pragma unroll
      for (int i = 0; i < 16; ++i) acc[nb][mb][i] = 0.f;
  const int x = h ^ ((r >> 1) & 7);
  int co[4];
#pragma unroll
  for (int st = 0; st < 4; ++st) co[st] = (x ^ (2 * st)) << 4;
  const int arow = (wm * 64 + r) * 128;
  const int brow = STG_A + (wn * 64 + r) * 128;
  auto issue_part = [&](int kt, int sidx, int part) {
    unsigned char* sa = lds + sidx * STG; unsigned char* sb = sa + STG_A;
    if (part == 0) {
#pragma unroll
      for (int i = 0; i < 2; ++i)
        __builtin_amdgcn_global_load_lds((const unsigned*)(pa[i] + kt * 64), (unsigned*)(sa + (wave * 2 + i) * 1024), 16, 0, 0);
    } else {
#pragma unroll
      for (int i = 2 * (part - 1); i < 2 * part; ++i)
        __builtin_amdgcn_global_load_lds((const unsigned*)(pb[i] + kt * 64), (unsigned*)(sb + (wave * 4 + i) * 1024), 16, 0, 0);
    }
  };
  auto issue = [&](int kt, int sidx) { issue_part(kt, sidx, 0); issue_part(kt, sidx, 1); issue_part(kt, sidx, 2); };
  const int nk = K >> 6;
  WAIT_VM(0);
  RAW_BARRIER();
  issue(0, 0); issue(1, 1);
  int sc = 0, sn = 2;
#pragma unroll 1
  for (int j = 0; j < nk; ++j) {
    if (j + 1 < nk) WAIT_VM(6); else WAIT_VM(0);
    RAW_BARRIER();
    const bool pre = (j + 2) < nk;
    const unsigned char* base = lds + sc * STG;
#pragma unroll
    for (int st = 0; st < 4; ++st) {
      const bf16x8 af0 = *(const bf16x8*)(base + arow + co[st]);
      const bf16x8 af1 = *(const bf16x8*)(base + arow + 4096 + co[st]);
      const bf16x8 bf0 = *(const bf16x8*)(base + brow + co[st]);
      const bf16x8 bf1 = *(const bf16x8*)(base + brow + 4096 + co[st]);
      acc[0][0] = MFMA(bf0, af0, acc[0][0]);
      acc[0][1] = MFMA(bf0, af1, acc[0][1]);
      acc[1][0] = MFMA(bf1, af0, acc[1][0]);
      acc[1][1] = MFMA(bf1, af1, acc[1][1]);
      if (st < 3 && pre) issue_part(j + 2, sn, st);
    }
    sc = (sc == 2) ? 0 : sc + 1; sn = (sn == 2) ? 0 : sn + 1;
  }
  epi(acc);
}

template <class Epi>
DI void gemm_multi(const bf16_t* __restrict__ A, int lda, const bf16_t* __restrict__ Bt, int ldb, int K, int ntiles, bf16_t* lds_, Epi epi) {
  unsigned char* lds = (unsigned char*)lds_;
  const int tid = otid(), lane = tid & 63, wave = tid >> 6;
  const int wm = wave & 1, wn = wave >> 1, r = lane & 31, h = lane >> 5;
  const int lr = lane >> 3, lcp = lane & 7;
  const bf16_t* pa[2]; const bf16_t* pb[4];
#pragma unroll
  for (int i = 0; i < 2; ++i) { const int row = (wave * 2 + i) * 8 + lr; pa[i] = A + (size_t)row * lda + ((lcp ^ ((row >> 1) & 7)) * 8); }
#pragma unroll
  for (int i = 0; i < 4; ++i) { const int row = (wave * 4 + i) * 8 + lr; pb[i] = Bt + (size_t)row * ldb + ((lcp ^ ((row >> 1) & 7)) * 8); }
  f32x16 acc[2][2];
#pragma unroll
  for (int nb = 0; nb < 2; ++nb)
#pragma unroll
    for (int mb = 0; mb < 2; ++mb)
#pragma unroll
      for (int i = 0; i < 16; ++i) acc[nb][mb][i] = 0.f;
  const int x = h ^ ((r >> 1) & 7);
  int co[4];
#pragma unroll
  for (int st = 0; st < 4; ++st) co[st] = (x ^ (2 * st)) << 4;
  const int arow = (wm * 64 + r) * 128;
  const int brow = STG_A + (wn * 64 + r) * 128;
  int pkt = 0; size_t pboff = 0;
  auto issue_part = [&](int sidx, int part) {
    unsigned char* sa = lds + sidx * STG; unsigned char* sb = sa + STG_A;
    if (part == 0) {
#pragma unroll
      for (int i = 0; i < 2; ++i)
        __builtin_amdgcn_global_load_lds((const unsigned*)(pa[i] + pkt * 64), (unsigned*)(sa + (wave * 2 + i) * 1024), 16, 0, 0);
    } else {
#pragma unroll
      for (int i = 2 * (part - 1); i < 2 * part; ++i)
        __builtin_amdgcn_global_load_lds((const unsigned*)(pb[i] + pboff + pkt * 64), (unsigned*)(sb + (wave * 4 + i) * 1024), 16, 0, 0);
    }
  };
  const int nk = K >> 6, total = ntiles * nk;
  const size_t bstep = (size_t)256 * ldb;
  RAW_BARRIER();
  issue_part(0, 1); issue_part(0, 2);
  if (nk > 1) { ++pkt; issue_part(1, 1); issue_part(1, 2); --pkt; }
  else { pkt = 0; pboff += bstep; issue_part(1, 1); issue_part(1, 2); pboff -= bstep; }
  WAIT_VM(8);
  RAW_BARRIER();
  issue_part(0, 0);
  if (++pkt == nk) { pkt = 0; pboff += bstep; }
  issue_part(1, 0);
  if (++pkt == nk) { pkt = 0; pboff += bstep; }
  int sc = 0, sn = 2, kt = 0, nt = 0;
#pragma unroll 1
  for (int j = 0; j < total; ++j) {
    if (j + 1 >= total) WAIT_VM(0); else if (j == 0) WAIT_VM(2); else WAIT_VM(6);
    RAW_BARRIER();
    const bool pre = (j + 2) < total;
    const unsigned char* base = lds + sc * STG;
    bf16x8 fa[2][2], fb[2][2];
    fa[0][0] = *(const bf16x8*)(base + arow + co[0]);
    fa[0][1] = *(const bf16x8*)(base + arow + 4096 + co[0]);
    fb[0][0] = *(const bf16x8*)(base + brow + co[0]);
    fb[0][1] = *(const bf16x8*)(base + brow + 4096 + co[0]);
#pragma unroll
    for (int st = 0; st < 4; ++st) {
      const int cur = st & 1, nxt = cur ^ 1;
      if (st < 3) {
        fa[nxt][0] = *(const bf16x8*)(base + arow + co[st + 1]);
        fa[nxt][1] = *(const bf16x8*)(base + arow + 4096 + co[st + 1]);
        fb[nxt][0] = *(const bf16x8*)(base + brow + co[st + 1]);
        fb[nxt][1] = *(const bf16x8*)(base + brow + 4096 + co[st + 1]);
      }
      asm volatile("" : "+v"(fa[cur][0]), "+v"(fa[cur][1]), "+v"(fb[cur][0]), "+v"(fb[cur][1]) :: "memory");
      acc[0][0] = MFMA(fb[cur][0], fa[cur][0], acc[0][0]);
      acc[0][1] = MFMA(fb[cur][0], fa[cur][1], acc[0][1]);
      acc[1][0] = MFMA(fb[cur][1], fa[cur][0], acc[1][0]);
      acc[1][1] = MFMA(fb[cur][1], fa[cur][1], acc[1][1]);
      if (st < 3 && pre) issue_part(sn, st);
    }
    if (pre) { if (++pkt == nk) { pkt = 0; pboff += bstep; } }
    sc = (sc == 2) ? 0 : sc + 1; sn = (sn == 2) ? 0 : sn + 1;
    if (++kt == nk) {
      RAW_BARRIER();
      epi(acc, nt, lds + sn * STG + wave * EPI_WAVE);
#pragma unroll
      for (int nb = 0; nb < 2; ++nb)
#pragma unroll
        for (int mb = 0; mb < 2; ++mb)
#pragma unroll
          for (int i = 0; i < 16; ++i) acc[nb][mb][i] = 0.f;
      kt = 0; ++nt;
    }
  }
}

template <class Epi>
DI void gemm_merge(const bf16_t* __restrict__ Ht, const unsigned char* segws, const bf16_t* __restrict__ WGj, const bf16_t* __restrict__ WBj, bf16_t* lds_, Epi epi) {
  unsigned char* lds = (unsigned char*)lds_;
  const int tid = otid(), lane = tid & 63, wave = tid >> 6;
  const int wm = wave & 1, wn = wave >> 1, r = lane & 31, h = lane >> 5;
  const int lr = lane >> 3, lcp = lane & 7;
  int oa1[2], oa5[2], ob1[4], ob5[4];
#pragma unroll
  for (int i = 0; i < 2; ++i) { const int row = (wave * 2 + i) * 8 + lr; const int cs = (lcp ^ ((row >> 1) & 7)) * 8; oa1[i] = row * 1024 + cs; oa5[i] = row * 512 + cs; }
#pragma unroll
  for (int i = 0; i < 4; ++i) { const int row = (wave * 4 + i) * 8 + lr; const int cs = (lcp ^ ((row >> 1) & 7)) * 8; ob1[i] = row * 1024 + cs; ob5[i] = row * 512 + cs; }
  f32x16 acc[2][2];
#pragma unroll
  for (int nb = 0; nb < 2; ++nb)
#pragma unroll
    for (int mb = 0; mb < 2; ++mb)
#pragma unroll
      for (int i = 0; i < 16; ++i) acc[nb][mb][i] = 0.f;
  const int x = h ^ ((r >> 1) & 7);
  int co[4];
#pragma unroll
  for (int st = 0; st < 4; ++st) co[st] = (x ^ (2 * st)) << 4;
  const int arow = (wm * 64 + r) * 128;
  const int brow = STG_A + (wn * 64 + r) * 128;
  int pseg = 0, pkt = 0;
  auto issue_part = [&](int sidx, int part) {
    unsigned char* sa = lds + sidx * STG; unsigned char* sb = sa + STG_A;
    const int n = pseg >> 1; const bool gate = (pseg & 1) == 0;
    if (part == 0) {
      const size_t offy = (n == 0) ? OFF_QA : (n == 1) ? OFF_QB : OFF_QCN;
      const bf16_t* ab = gate ? Ht : (const bf16_t*)(segws + offy);
#pragma unroll
      for (int i = 0; i < 2; ++i)
        __builtin_amdgcn_global_load_lds((const unsigned*)(ab + (gate ? oa1[i] : oa5[i]) + pkt * 64), (unsigned*)(sa + (wave * 2 + i) * 1024), 16, 0, 0);
    } else {
      const bf16_t* bb = gate ? (WGj + (size_t)n * 1024 * 1024) : (WBj + (size_t)n * 1024 * 512);
#pragma unroll
      for (int i = 2 * (part - 1); i < 2 * part; ++i)
        __builtin_amdgcn_global_load_lds((const unsigned*)(bb + (gate ? ob1[i] : ob5[i]) + pkt * 64), (unsigned*)(sb + (wave * 4 + i) * 1024), 16, 0, 0);
    }
  };
  auto advance = [&]() { if (++pkt == ((pseg & 1) ? 8 : 16)) { pkt = 0; ++pseg; } };
  constexpr int total = 3 * (16 + 8);
  WAIT_VM(0);
  RAW_BARRIER();
  issue_part(0, 0); issue_part(0, 1); issue_part(0, 2); advance();
  issue_part(1, 0); issue_part(1, 1); issue_part(1, 2); advance();
  int sc = 0, sn = 2, kt = 0, cseg = 0;
#pragma unroll 1
  for (int j = 0; j < total; ++j) {
    if (j + 1 < total) WAIT_VM(6); else WAIT_VM(0);
    RAW_BARRIER();
    const bool pre = (j + 2) < total;
    const unsigned char* base = lds + sc * STG;
    bf16x8 fa[2][2], fb[2][2];
    fa[0][0] = *(const bf16x8*)(base + arow + co[0]);
    fa[0][1] = *(const bf16x8*)(base + arow + 4096 + co[0]);
    fb[0][0] = *(const bf16x8*)(base + brow + co[0]);
    fb[0][1] = *(const bf16x8*)(base + brow + 4096 + co[0]);
#pragma unroll
    for (int st = 0; st < 4; ++st) {
      const int cur = st & 1, nxt = cur ^ 1;
      if (st < 3) {
        fa[nxt][0] = *(const bf16x8*)(base + arow + co[st + 1]);
        fa[nxt][1] = *(const bf16x8*)(base + arow + 4096 + co[st + 1]);
        fb[nxt][0] = *(const bf16x8*)(base + brow + co[st + 1]);
        fb[nxt][1] = *(const bf16x8*)(base + brow + 4096 + co[st + 1]);
      }
      asm volatile("" : "+v"(fa[cur][0]), "+v"(fa[cur][1]), "+v"(fb[cur][0]), "+v"(fb[cur][1]) :: "memory");
      acc[0][0] = MFMA(fb[cur][0], fa[cur][0], acc[0][0]);
      acc[0][1] = MFMA(fb[cur][0], fa[cur][1], acc[0][1]);
      acc[1][0] = MFMA(fb[cur][1], fa[cur][0], acc[1][0]);
      acc[1][1] = MFMA(fb[cur][1], fa[cur][1], acc[1][1]);
      if (st < 3 && pre) issue_part(sn, st);
    }
    if (pre) advance();
    sc = (sc == 2) ? 0 : sc + 1; sn = (sn == 2) ? 0 : sn + 1;
    if (++kt == ((cseg & 1) ? 8 : 16)) {
      epi(acc, cseg);
#pragma unroll
      for (int nb = 0; nb < 2; ++nb)
#pragma unroll
        for (int mb = 0; mb < 2; ++mb)
#pragma unroll
          for (int i = 0; i < 16; ++i) acc[nb][mb][i] = 0.f;
      kt = 0; ++cseg;
    }
  }
}

DI void rot32(const f32x16& v, const float* mul, float sc, const float2* __restrict__ tab, int h, float* o) {
#pragma unroll
  for (int i = 0; i < 8; ++i) {
    const int j = crow(i, h);
    const float2 cs = tab[j];
    const float x1 = v[i] * sc * (mul ? mul[j] : 1.f), x2 = v[i + 8] * sc * (mul ? mul[j + 16] : 1.f);
    o[i] = x1 * cs.x - x2 * cs.y;
    o[i + 8] = x2 * cs.x + x1 * cs.y;
  }
}

struct WS {
  bf16_t *QA, *KA, *VAT, *QB, *KB, *VBT, *QCN, *QCR, *KCN, *KR, *VCT, *H, *T2;
  bf16_t *WP1, *WUQ, *WUKV, *WG, *WB, *WO, *W1, *W2;
  float2 *TABC, *TABB; float* LAM;
};
DI WS make_ws(unsigned char* ws) {
  WS w;
  w.QA = (bf16_t*)(ws + OFF_QA); w.KA = (bf16_t*)(ws + OFF_KA); w.VAT = (bf16_t*)(ws + OFF_VAT);
  w.QB = (bf16_t*)(ws + OFF_QB); w.KB = (bf16_t*)(ws + OFF_KB); w.VBT = (bf16_t*)(ws + OFF_VBT);
  w.QCN = (bf16_t*)(ws + OFF_QCN); w.QCR = (bf16_t*)(ws + OFF_QCR); w.KCN = (bf16_t*)(ws + OFF_KCN);
  w.KR = (bf16_t*)(ws + OFF_KR); w.VCT = (bf16_t*)(ws + OFF_VCT); w.H = (bf16_t*)(ws + OFF_H); w.T2 = (bf16_t*)(ws + OFF_T2);
  w.WP1 = (bf16_t*)(ws + OFF_WP1); w.WUQ = (bf16_t*)(ws + OFF_WUQ); w.WUKV = (bf16_t*)(ws + OFF_WUKV);
  w.WG = (bf16_t*)(ws + OFF_WG); w.WB = (bf16_t*)(ws + OFF_WB); w.WO = (bf16_t*)(ws + OFF_WO);
  w.W1 = (bf16_t*)(ws + OFF_W1); w.W2 = (bf16_t*)(ws + OFF_W2);
  w.TABC = (float2*)(ws + OFF_TABC); w.TABB = (float2*)(ws + OFF_TABB); w.LAM = (float*)(ws + OFF_LAM);
  return w;
}

DI void p1_epi(f32x16 (&acc)[2][2], int ntile, int tok0, const WS& w, const float* __restrict__ aqg, const float* __restrict__ akg, bf16_t* CQ, bf16_t* CKV, unsigned char* sl, float* ssq) {
  const int tid_ = otid();
  const int lane = tid_ & 63, wave = tid_ >> 6;
  const int wm = wave & 1, wn = wave >> 1, r = lane & 31, h = lane >> 5;
  const int c64 = ntile * 256 + wn * 64;
  if (c64 >= NP1) return;
#pragma unroll
  for (int mb = 0; mb < 2; ++mb) {
    const int tl = wm * 64 + mb * 32 + r;
    const int t = tok0 + tl;
    const int s = t & (SEQ - 1), b = t >> 11;
    float oc[2][16];
    if (c64 < 640) {
      const bool isq = c64 < 512;
      const float* g = isq ? aqg : akg;
      float ss = 0.f;
#pragma unroll
      for (int nb = 0; nb < 2; ++nb)
#pragma unroll
        for (int i = 0; i < 16; ++i) ss += acc[nb][mb][i] * acc[nb][mb][i];
      ss = xh_sum(ss);
      const float rs = rsqrtf(ss * (1.f / 64.f) + EPS) * (isq ? 0.125f * LOG2E : 1.f);
      const int t0 = tok0 + wm * 64 + mb * 32;
      bf16_t* dst0 = isq ? (w.QA + (size_t)t0 * 512 + c64) : (w.KA + (size_t)t0 * 128 + (c64 - 512));
      float o2[2][16];
#pragma unroll
      for (int nb = 0; nb < 2; ++nb) {
        const int pos = (nb == 0) ? (s >> 6) : (s & 63);
        rot32(acc[nb][mb], g + nb * 32, rs, w.TABC + pos * 16, h, o2[nb]);
      }
      wave_rows_bf16(sl, o2, dst0, isq ? 512 : 128, lane);
    } else if (c64 < 768) {
      const int kvh = (c64 - 640) >> 6;
#pragma unroll
      for (int nb = 0; nb < 2; ++nb)
        store16T(w.VAT + ((size_t)(b * 2 + kvh) * 64 + nb * 32) * SEQ + vperm(s), acc[nb][mb], 1.f, h);
    } else if (c64 < 1792) {
      const bool isq = c64 < 1280;
      const float sc = isq ? 0.17677669529663687f * LOG2E : 1.f;
      const int t0 = tok0 + wm * 64 + mb * 32;
      bf16_t* dst0 = isq ? (w.QB + (size_t)t0 * 512 + (c64 - 768)) : (w.KB + (size_t)t0 * 512 + (c64 - 1280));
      float o2[2][16];
#pragma unroll
      for (int nb = 0; nb < 2; ++nb) {
#pragma unroll
        for (int i = 0; i < 16; ++i) o2[nb][i] = acc[nb][mb][i] * sc;
#pragma unroll
        for (int i = 0; i < 4; ++i) {
          const float other = xh_other(o2[nb][i], h);
          const float2 cs = w.TABB[s * 4 + i];
          o2[nb][i] = h ? (o2[nb][i] * cs.x + other * cs.y) : (o2[nb][i] * cs.x - other * cs.y);
        }
      }
      wave_rows_bf16(sl, o2, dst0, 512, lane);
    } else if (c64 < 2304) {
      const int hd = (c64 - 1792) >> 6;
#pragma unroll
      for (int nb = 0; nb < 2; ++nb)
        store16T(w.VBT + ((size_t)(b * 8 + hd) * 64 + nb * 32) * SEQ + vperm(s), acc[nb][mb], 1.f, h);
    } else if (c64 < 2688) {
#pragma unroll
      for (int nb = 0; nb < 2; ++nb)
#pragma unroll
        for (int i = 0; i < 16; ++i) oc[nb][i] = acc[nb][mb][i];
      {
        float ss = 0.f;
#pragma unroll
        for (int nb = 0; nb < 2; ++nb)
#pragma unroll
          for (int i = 0; i < 16; ++i) ss += oc[nb][i] * oc[nb][i];
        ss = xh_sum(ss);
        if (h == 0) ssq[((c64 - 2304) >> 6) * 128 + tl] = ss;
      }
      wave_rows_bf16(sl, oc, CQ + (size_t)(wm * 64 + mb * 32) * 384 + (c64 - 2304), 384, lane);
    } else if (c64 < 2944) {
#pragma unroll
      for (int nb = 0; nb < 2; ++nb)
#pragma unroll
        for (int i = 0; i < 16; ++i) oc[nb][i] = acc[nb][mb][i];
      {
        float ss = 0.f;
#pragma unroll
        for (int nb = 0; nb < 2; ++nb)
#pragma unroll
          for (int i = 0; i < 16; ++i) ss += oc[nb][i] * oc[nb][i];
        ss = xh_sum(ss);
        if (h == 0) ssq[(6 + ((c64 - 2688) >> 6)) * 128 + tl] = ss;
      }
      wave_rows_bf16(sl, oc, CKV + (size_t)(wm * 64 + mb * 32) * 256 + (c64 - 2688), 256, lane);
    } else {
      float o[16];
      rot32(acc[0][mb], nullptr, 1.f, w.TABC + s * 16, h, o);
      store16(w.KR + (size_t)t * 32, o, h);
    }
  }
}

template <int DQK>
DI void flash(const bf16x8* qf, const bf16_t* __restrict__ K1, int ld1, const bf16_t* __restrict__ K2, int ld2,
              const bf16_t* __restrict__ Vt, bf16_t* lds, f32x16 (&ot)[2], float& lsum) {
  constexpr int KROW = DQK + 8, CPR = DQK / 8, NCH = 64 * CPR, NS = DQK / 16;
  const int tid = otid(), lane = tid & 63;
  const int r = lane & 31, h = lane >> 5;
  const int id0 = tid, id1 = tid + 512;
  const bool v0 = id0 < NCH, v1 = id1 < NCH;
  const int row0 = id0 / CPR, c0 = id0 % CPR, row1 = id1 / CPR, c1 = id1 % CPR;
  const bf16_t* kp0; size_t ks0;
  const bf16_t* kp1; size_t ks1;
  if (DQK == 96 && c0 >= 8) { kp0 = K2 + (size_t)row0 * ld2 + (c0 - 8) * 8; ks0 = (size_t)64 * ld2; }
  else { kp0 = K1 + (size_t)row0 * ld1 + c0 * 8; ks0 = (size_t)64 * ld1; }
  if (DQK == 96 && c1 >= 8) { kp1 = K2 + (size_t)row1 * ld2 + (c1 - 8) * 8; ks1 = (size_t)64 * ld2; }
  else { kp1 = K1 + (size_t)row1 * ld1 + c1 * 8; ks1 = (size_t)64 * ld1; }
  const int lk0 = row0 * KROW + c0 * 8, lk1 = row1 * KROW + c1 * 8;
  const int vd = tid >> 3, vc = (tid & 7) * 8;
  const bf16_t* vp = Vt + (size_t)vd * SEQ + vc;
  const int lv = vd * VROW + vc;
#pragma unroll
  for (int db = 0; db < 2; ++db)
#pragma unroll
    for (int i = 0; i < 16; ++i) ot[db][i] = 0.f;
  f32x16 NM;
#pragma unroll
  for (int i = 0; i < 16; ++i) NM[i] = 0.f;
  float lacc = 0.f;
  uint4 rk0 = {0, 0, 0, 0}, rk1 = {0, 0, 0, 0}, rv;
  __syncthreads();
  if (v0) rk0 = *(const uint4*)kp0;
  if (v1) rk1 = *(const uint4*)kp1;
  rv = *(const uint4*)vp;
  {
    bf16_t* sk = lds; bf16_t* sv = lds + KST;
    if (v0) *(uint4*)(sk + lk0) = rk0;
    if (v1) *(uint4*)(sk + lk1) = rk1;
    *(uint4*)(sv + lv) = rv;
  }
  __syncthreads();
  constexpr int NTILE = SEQ / 64;
#pragma unroll 1
  for (int kt = 0; kt < NTILE; ++kt) {
    const bf16_t* sk = lds + (kt & 1) * AT_STAGE; const bf16_t* sv = sk + KST;
    const bool more = (kt + 1) < NTILE;
    if (more) {
      if (v0) rk0 = *(const uint4*)(kp0 + (size_t)(kt + 1) * ks0);
      if (v1) rk1 = *(const uint4*)(kp1 + (size_t)(kt + 1) * ks1);
      rv = *(const uint4*)(vp + (kt + 1) * 64);
    }
    f32x16 st[2];
    bf16x8 kf[2][NS];
#pragma unroll
    for (int kb = 0; kb < 2; ++kb)
#pragma unroll
      for (int s = 0; s < NS; ++s) kf[kb][s] = *(const bf16x8*)(sk + (kb * 32 + r) * KROW + s * 16 + h * 8);
    __builtin_amdgcn_sched_barrier(0);
#pragma unroll
    for (int s = 0; s < NS; ++s)
#pragma unroll
      for (int kb = 0; kb < 2; ++kb) st[kb] = MFMA(kf[kb][s], qf[s], (s == 0) ? NM : st[kb]);
    bf16x8 vfr[2][2][2];
#pragma unroll
    for (int kb = 0; kb < 2; ++kb)
#pragma unroll
      for (int s = 0; s < 2; ++s)
#pragma unroll
        for (int db = 0; db < 2; ++db) vfr[kb][s][db] = *(const bf16x8*)(sv + (db * 32 + r) * VROW + kb * 32 + 16 * s + 8 * h);
    __builtin_amdgcn_sched_barrier(0);
    float mx = st[0][0];
#pragma unroll
    for (int i = 1; i < 16; ++i) mx = fmaxf(mx, st[0][i]);
#pragma unroll
    for (int i = 0; i < 16; ++i) mx = fmaxf(mx, st[1][i]);
    mx = xh_max(mx);
    if (kt == 0 || __any(mx > 8.f)) {
      const float d = (kt == 0) ? mx : fmaxf(mx, 0.f);
      const float alpha = ex2(-d);
#pragma unroll
      for (int kb = 0; kb < 2; ++kb)
#pragma unroll
        for (int i = 0; i < 16; ++i) st[kb][i] -= d;
#pragma unroll
      for (int i = 0; i < 16; ++i) NM[i] -= d;
      if (kt != 0) {
#pragma unroll
        for (int db = 0; db < 2; ++db)
#pragma unroll
          for (int i = 0; i < 16; ++i) ot[db][i] *= alpha;
        lacc *= alpha;
      }
    }
#pragma unroll
    for (int kb = 0; kb < 2; ++kb)
#pragma unroll
      for (int s = 0; s < 2; ++s) {
        typedef __attribute__((ext_vector_type(4))) unsigned u32x4;
        u32x4 pp;
#pragma unroll
        for (int e = 0; e < 4; ++e) {
          const float p0 = ex2(st[kb][8 * s + 2 * e]), p1 = ex2(st[kb][8 * s + 2 * e + 1]);
          lacc += p0 + p1;
          pp[e] = pk2(p0, p1);
        }
        const bf16x8 pf = __builtin_bit_cast(bf16x8, pp);
#pragma unroll
        for (int db = 0; db < 2; ++db) ot[db] = MFMA(vfr[kb][s][db], pf, ot[db]);
      }
    if (more) {
      bf16_t* nk_ = lds + ((kt + 1) & 1) * AT_STAGE; bf16_t* nv = nk_ + KST;
      if (v0) *(uint4*)(nk_ + lk0) = rk0;
      if (v1) *(uint4*)(nk_ + lk1) = rk1;
      *(uint4*)(nv + lv) = rv;
    }
    __syncthreads();
  }
  const float l = lacc;
  lsum = xh_sum(l);
}

DI void flash_b(const bf16x8* qf, const bf16_t* __restrict__ K1, int ld1, const bf16_t* __restrict__ Vt, bf16_t* lds,
                f32x16 (&ot)[2][2], float (&lsum)[2]) {
  constexpr int KROW = 72;
  const int tid = otid(), lane = tid & 63;
  const int r = lane & 31, h = lane >> 5;
  const int row0 = tid >> 3, c0 = tid & 7;
  const bf16_t* kp0 = K1 + (size_t)row0 * ld1 + c0 * 8; const size_t ks0 = (size_t)64 * ld1;
  const int lk0 = row0 * KROW + c0 * 8;
  const int vd = tid >> 3, vc = (tid & 7) * 8;
  const bf16_t* vp = Vt + (size_t)vd * SEQ + vc;
  const int lv = vd * VROW + vc;
  f32x16 NM[2];
  float lacc[2] = {0.f, 0.f};
#pragma unroll
  for (int c = 0; c < 2; ++c) {
#pragma unroll
    for (int i = 0; i < 16; ++i) { NM[c][i] = 0.f; ot[c][0][i] = 0.f; ot[c][1][i] = 0.f; }
  }
  uint4 rk0, rv;
  __syncthreads();
  rk0 = *(const uint4*)kp0;
  rv = *(const uint4*)vp;
  *(uint4*)(lds + lk0) = rk0;
  *(uint4*)(lds + KST + lv) = rv;
  __syncthreads();
  constexpr int NTILE = SEQ / 64;
#pragma unroll 1
  for (int kt = 0; kt < NTILE; ++kt) {
    const bf16_t* sk = lds + (kt & 1) * AT_STAGE; const bf16_t* sv = sk + KST;
    const bool more = (kt + 1) < NTILE;
    if (more) { rk0 = *(const uint4*)(kp0 + (size_t)(kt + 1) * ks0); rv = *(const uint4*)(vp + (kt + 1) * 64); }
    bf16x8 vfr[2][2][2];
#pragma unroll
    for (int kb = 0; kb < 2; ++kb)
#pragma unroll
      for (int s = 0; s < 2; ++s)
#pragma unroll
        for (int db = 0; db < 2; ++db) vfr[kb][s][db] = *(const bf16x8*)(sv + (db * 32 + r) * VROW + kb * 32 + 16 * s + 8 * h);
    __builtin_amdgcn_sched_barrier(0);
#pragma unroll
    for (int c = 0; c < 2; ++c) {
      f32x16 st[2];
      bf16x8 kf[2][2];
#pragma unroll
      for (int kb = 0; kb < 2; ++kb)
#pragma unroll
        for (int s = 0; s < 2; ++s) kf[kb][s] = *(const bf16x8*)(sk + (kb * 32 + r) * KROW + (2 * c + s) * 16 + h * 8);
#pragma unroll
      for (int s = 0; s < 2; ++s)
#pragma unroll
        for (int kb = 0; kb < 2; ++kb) st[kb] = MFMA(kf[kb][s], qf[2 * c + s], (s == 0) ? NM[c] : st[kb]);
      float mx = st[0][0];
#pragma unroll
      for (int i = 1; i < 16; ++i) mx = fmaxf(mx, st[0][i]);
#pragma unroll
      for (int i = 0; i < 16; ++i) mx = fmaxf(mx, st[1][i]);
      mx = xh_max(mx);
      if (kt == 0 || __any(mx > 8.f)) {
        const float d = (kt == 0) ? mx : fmaxf(mx, 0.f);
        const float alpha = ex2(-d);
#pragma unroll
        for (int kb = 0; kb < 2; ++kb)
#pragma unroll
          for (int i = 0; i < 16; ++i) st[kb][i] -= d;
#pragma unroll
        for (int i = 0; i < 16; ++i) NM[c][i] -= d;
        if (kt != 0) {
#pragma unroll
          for (int db = 0; db < 2; ++db)
#pragma unroll
            for (int i = 0; i < 16; ++i) ot[c][db][i] *= alpha;
          lacc[c] *= alpha;
        }
      }
#pragma unroll
      for (int kb = 0; kb < 2; ++kb)
#pragma unroll
        for (int s = 0; s < 2; ++s) {
          typedef __attribute__((ext_vector_type(4))) unsigned u32x4;
          u32x4 pp;
#pragma unroll
          for (int e = 0; e < 4; ++e) {
            const float p0 = ex2(st[kb][8 * s + 2 * e]), p1 = ex2(st[kb][8 * s + 2 * e + 1]);
            lacc[c] += p0 + p1;
            pp[e] = pk2(p0, p1);
          }
          const bf16x8 pf = __builtin_bit_cast(bf16x8, pp);
#pragma unroll
          for (int db = 0; db < 2; ++db) ot[c][db] = MFMA(vfr[kb][s][db], pf, ot[c][db]);
        }
    }
    if (more) {
      bf16_t* nk_ = lds + ((kt + 1) & 1) * AT_STAGE;
      *(uint4*)(nk_ + lk0) = rk0;
      *(uint4*)(nk_ + KST + lv) = rv;
    }
    __syncthreads();
  }
#pragma unroll
  for (int c = 0; c < 2; ++c) lsum[c] = xh_sum(lacc[c]);
}

DI bf16x8 ldq(const bf16_t* p) { return *(const bf16x8*)p; }

DI void attn_item(const WS& w, int type, int b, int head, int qt, bf16_t* lds, float lam, float post, const float* __restrict__ subg) {
  const int tid_ = otid();
  const int lane = tid_ & 63, wave = tid_ >> 6;
  const int r = lane & 31, h = lane >> 5;
  const int t = b * SEQ + qt * 256 + wave * 32 + r;
  f32x16 ot[2]; float l;
  if (type == 2) {
    const int kvh = head >> 2;
    bf16_t* qrow = w.QA + (size_t)t * 512 + head * 64;
    bf16x8 qf[4];
#pragma unroll
    for (int s = 0; s < 4; ++s) qf[s] = ldq(qrow + s * 16 + h * 8);
    flash<64>(qf, w.KA + (size_t)b * SEQ * 128 + kvh * 64, 128, nullptr, 0, w.VAT + (size_t)(b * 2 + kvh) * 64 * SEQ, lds, ot, l);
    const float inv = 1.f / l;
    float o2[2][16];
#pragma unroll
    for (int db = 0; db < 2; ++db)
#pragma unroll
      for (int i = 0; i < 16; ++i) o2[db][i] = ot[db][i] * inv;
    wave_rows_bf16((unsigned char*)lds + wave * EPI_WAVE, o2, w.QA + (size_t)(t - r) * 512 + head * 64, 512, lane);
  } else if (type == 1) {
    bf16_t* qrow = w.QCN + (size_t)t * 512 + head * 64;
    const bf16_t* qr2 = w.QCR + (size_t)t * 256 + head * 32;
    bf16x8 qf[6];
#pragma unroll
    for (int s = 0; s < 4; ++s) qf[s] = ldq(qrow + s * 16 + h * 8);
#pragma unroll
    for (int s = 0; s < 2; ++s) qf[4 + s] = ldq(qr2 + s * 16 + h * 8);
    flash<96>(qf, w.KCN + (size_t)b * SEQ * 512 + head * 64, 512, w.KR + (size_t)b * SEQ * 32, 32, w.VCT + (size_t)(b * 8 + head) * 64 * SEQ, lds, ot, l);
    const float inv = 1.f / l;
    float o2[2][16];
#pragma unroll
    for (int db = 0; db < 2; ++db)
#pragma unroll
      for (int i = 0; i < 16; ++i) o2[db][i] = ot[db][i] * inv;
    wave_rows_bf16((unsigned char*)lds + wave * EPI_WAVE, o2, w.QCN + (size_t)(t - r) * 512 + head * 64, 512, lane);
  } else {
    bf16_t* qrow = w.QB + (size_t)t * 512 + head * 64;
    bf16x8 qfb[4];
#pragma unroll
    for (int s = 0; s < 2; ++s) { qfb[s] = ldq(qrow + s * 16 + h * 8); qfb[2 + s] = ldq(qrow + 32 + s * 16 + h * 8); }
    const bf16_t* kb = w.KB + (size_t)b * SEQ * 512 + head * 64;
    const bf16_t* vt = w.VBT + (size_t)(b * 8 + head) * 64 * SEQ;
    f32x16 ob[2][2]; float lb[2];
    flash_b(qfb, kb, 512, vt, lds, ob, lb);
    const float i0 = 1.f / lb[0], i1 = lam / lb[1];
    float ss = 0.f;
#pragma unroll
    for (int db = 0; db < 2; ++db)
#pragma unroll
      for (int i = 0; i < 16; ++i) { const float o = i0 * ob[0][db][i] - i1 * ob[1][db][i]; ot[db][i] = o; ss += o * o; }
    ss = xh_sum(ss);
    const float rs = rsqrtf(ss * (1.f / 64.f) + EPS) * post;
    float o2[2][16];
#pragma unroll
    for (int db = 0; db < 2; ++db)
#pragma unroll
      for (int i = 0; i < 16; ++i) o2[db][i] = ot[db][i] * rs * subg[db * 32 + crow(i, h)];
    wave_rows_bf16((unsigned char*)lds + wave * EPI_WAVE, o2, w.QB + (size_t)(t - r) * 512 + head * 64, 512, lane);
  }
}

__global__ void __launch_bounds__(512) fwd_kernel(Params p) {
  extern __shared__ __attribute__((aligned(16))) unsigned char lds_raw[];
  cg::grid_group grid = cg::this_grid();
  bf16_t* lds = (bf16_t*)lds_raw;
  float* ldsf = (float*)lds_raw;
  float* rstd = (float*)(lds_raw + LDS_RSTD_OFF);
  float* ssq = (float*)(lds_raw + LDS_SSQ_OFF);
  const WS w = make_ws(p.ws);
  const int tid = threadIdx.x, lane = tid & 63, wave = tid >> 6;
  const int wm = wave & 1, wn = wave >> 1, r = lane & 31, h = lane >> 5;
  const int G = gridDim.x;

  for (int i = blockIdx.x * 512 + tid; i < 2048 * 16; i += G * 512) {
    const int pos = i >> 4, j = i & 15;
    const float inv = powf(10000.f, -(float)(2 * j) / 32.f);
    const float ang = (float)pos * inv;
    w.TABC[i] = make_float2(cosf(ang), sinf(ang));
  }
  for (int i = blockIdx.x * 512 + tid; i < 2048 * 4; i += G * 512) {
    const int pos = i >> 2, j = i & 3;
    const float inv = powf(500000.f, -(float)(2 * j) / 8.f);
    const float ang = (float)pos * inv;
    w.TABB[i] = make_float2(cosf(ang), sinf(ang));
  }
  if (blockIdx.x == 0 && tid < DEPTH) {
    const float* lf = p.b_lambda + tid * 128;
    float s1 = 0.f, s2 = 0.f;
    for (int i = 0; i < 32; ++i) { s1 += lf[i] * lf[32 + i]; s2 += lf[64 + i] * lf[96 + i]; }
    w.LAM[tid] = expf(s1) - expf(s2) + p.lam_init[tid];
  }
  convert_T(p.w_in, INC, 1024, NP1, w.WP1, 1024, nullptr, ldsf);
  convert_T(p.c_w_uq, 768, 384, 768, w.WUQ, 384, p.c_q_norm, ldsf);
  convert_T(p.c_w_ukv, 1024, 256, 1024, w.WUKV, 256, p.c_kv_norm, ldsf);
  grid.sync();

  for (int layer = 0; layer < DEPTH; ++layer) {
    bf16_t* xb = (bf16_t*)p.out + (size_t)NT * DM;
    for (int tile = blockIdx.x; tile < NT / 128; tile += G) {
      const int tok0 = tile * 128;
      bf16_t* Ht = w.H + (size_t)tok0 * DM;
      bf16_t* CQ = w.T2 + (size_t)tok0 * 2048;
      bf16_t* CKV = CQ + 128 * 384;
      __syncthreads();
      if (layer == 0) rmsnorm_tile<false>(p.x + (size_t)tok0 * DM, p.ln1_g, Ht, nullptr);
      else rmsnorm_tile_b(xb + (size_t)tok0 * DM, p.ln1_g + layer * DM, Ht);
      const float* aqg = p.a_q_norm + layer * 64; const float* akg = p.a_k_norm + layer * 64;
      gemm_multi(Ht, DM, w.WP1, 1024, 1024, 12, lds,
                 [&](f32x16 (&acc)[2][2], int nt, unsigned char* sl) {
          const int t__ = otid(); const int lane = t__ & 63, wave = t__ >> 6, wm = wave & 1, wn = wave >> 1, r = lane & 31, h = lane >> 5; (void)wm; (void)wn; (void)r; (void)h; (void)lane; p1_epi(acc, nt, tok0, w, aqg, akg, CQ, CKV, sl, ssq); });
      __syncthreads();
      if (tid < 256) {
        const int t_ = tid & 127;
        float ssum = 0.f;
        if (tid < 128) { for (int q = 0; q < 6; ++q) ssum += ssq[q * 128 + t_]; rstd[tid] = rsqrtf(ssum * (1.f / 384.f) + EPS); }
        else { for (int q = 0; q < 4; ++q) ssum += ssq[(6 + q) * 128 + t_]; rstd[tid] = rsqrtf(ssum * (1.f / 256.f) + EPS); }
      }
      gemm_multi(CQ, 384, w.WUQ, 384, 384, 3, lds, [&](f32x16 (&acc)[2][2], int nt, unsigned char*) {
          const int t__ = otid(); const int lane = t__ & 63, wave = t__ >> 6, wm = wave & 1, wn = wave >> 1, r = lane & 31, h = lane >> 5; (void)wm; (void)wn; (void)r; (void)h; (void)lane;
#pragma unroll
          for (int nb = 0; nb < 2; ++nb) {
            const int g32 = nt * 8 + wn * 2 + nb, hd = g32 / 3, part = g32 % 3;
#pragma unroll
            for (int mb = 0; mb < 2; ++mb) {
              const int tl = wm * 64 + mb * 32 + r, t = tok0 + tl, s = t & (SEQ - 1);
              const float rs = rstd[tl] * (0.10206207261596577f * LOG2E);
              if (part < 2) store16v(w.QCN + (size_t)t * 512 + hd * 64 + part * 32, acc[nb][mb], rs, h);
              else { float o[16]; rot32(acc[nb][mb], nullptr, rs, w.TABC + s * 16, h, o); store16(w.QCR + (size_t)t * 256 + hd * 32, o, h); }
            }
          }
        });
      gemm_multi(CKV, 256, w.WUKV, 256, 256, 4, lds, [&](f32x16 (&acc)[2][2], int nt, unsigned char*) {
          const int t__ = otid(); const int lane = t__ & 63, wave = t__ >> 6, wm = wave & 1, wn = wave >> 1, r = lane & 31, h = lane >> 5; (void)wm; (void)wn; (void)r; (void)h; (void)lane;
#pragma unroll
          for (int nb = 0; nb < 2; ++nb) {
            const int g32 = nt * 8 + wn * 2 + nb, hd = g32 >> 2, part = g32 & 3;
#pragma unroll
            for (int mb = 0; mb < 2; ++mb) {
              const int tl = wm * 64 + mb * 32 + r, t = tok0 + tl, s = t & (SEQ - 1), b = t >> 11;
              const float rs = rstd[128 + tl];
              if (part < 2) store16v(w.KCN + (size_t)t * 512 + hd * 64 + part * 32, acc[nb][mb], rs, h);
              else store16T(w.VCT + ((size_t)(b * 8 + hd) * 64 + (part - 2) * 32) * SEQ + vperm(s), acc[nb][mb], rs, h);
            }
          }
        });
    }
    grid.sync();

    {
      const float* win = p.w_in + (size_t)layer * 1024 * INC;
      convert_T(win + NP1, INC, 1024, 3072, w.WG, 1024, nullptr, ldsf);
      for (int n = 0; n < 3; ++n)
        convert_T(p.w_branch + (size_t)(layer * 3 + n) * 512 * 1024, 1024, 512, 1024, w.WB + (size_t)n * 1024 * 512, 512, nullptr, ldsf);
      convert_T(p.w_out + (size_t)layer * 1024 * 1024, 1024, 1024, 1024, w.WO, 1024, nullptr, ldsf);
      convert_T(p.w_ff1 + (size_t)layer * 1024 * 4096, 4096, 1024, 4096, w.W1, 1024, nullptr, ldsf);
      convert_T(p.w_ff2 + (size_t)layer * 4096 * 1024, 1024, 4096, 1024, w.W2, 4096, nullptr, ldsf);
      if (layer + 1 < DEPTH) {
        const int l1 = layer + 1;
        convert_T(p.w_in + (size_t)l1 * 1024 * INC, INC, 1024, NP1, w.WP1, 1024, nullptr, ldsf);
        convert_T(p.c_w_uq + (size_t)l1 * 384 * 768, 768, 384, 768, w.WUQ, 384, p.c_q_norm + l1 * 384, ldsf);
        convert_T(p.c_w_ukv + (size_t)l1 * 256 * 1024, 1024, 256, 1024, w.WUKV, 256, p.c_kv_norm + l1 * 256, ldsf);
      }
      const float lam = w.LAM[layer];
      const float post = 1.f - p.lam_init[layer];
      const float* subg = p.b_subln + layer * 64;
      for (int v = blockIdx.x; v < 3072; v += G) {
        const int type = v >> 10, wi = v & 1023;
        const int k = wi >> 8, blk = wi & 255, xc = blk & 7, j = blk >> 3;
        int b, head; const int qt = j & 7;
        if (type == 2) { const int pair = k * 8 + xc; b = pair >> 1; head = (pair & 1) * 4 + (j >> 3); }
        else { const int pair = (k * 8 + xc) * 4 + (j >> 3); b = pair >> 3; head = pair & 7; }
        attn_item(w, type, b, head, qt, lds, lam, post, subg);
      }
    }
    grid.sync();

    for (int tile = blockIdx.x; tile < NT / 128; tile += G) {
      const int tok0 = tile * 128;
      bf16_t* Ht = w.H + (size_t)tok0 * DM;
      bf16_t* MG = w.T2 + (size_t)tok0 * 2048;
      uint4* GT = (uint4*)(w.QCR + (size_t)tok0 * 256);
      bf16_t* xt = xb + (size_t)tok0 * DM;
      const float* xin = p.x + (size_t)tok0 * DM;
      const unsigned char* segw = p.ws + (size_t)tok0 * 1024;
      for (int jt = 0; jt < 4; ++jt) {
        f32x16 mg[2][2];
#pragma unroll
        for (int nb = 0; nb < 2; ++nb)
#pragma unroll
          for (int mb = 0; mb < 2; ++mb)
#pragma unroll
            for (int i = 0; i < 16; ++i) mg[nb][mb][i] = 0.f;
        gemm_merge(Ht, p.ws + (size_t)tok0 * 1024, w.WG + (size_t)jt * 256 * 1024, w.WB + (size_t)jt * 256 * 512, lds, [&](f32x16 (&acc)[2][2], int sg) {
          const int t__ = otid(); const int lane = t__ & 63, wave = t__ >> 6;
          if ((sg & 1) == 0) {
#pragma unroll
            for (int nb = 0; nb < 2; ++nb)
#pragma unroll
              for (int mb = 0; mb < 2; ++mb) {
                unsigned gq[8];
#pragma unroll
                for (int i = 0; i < 8; ++i) {
                  const float g0 = __builtin_amdgcn_rcpf(1.f + ex2(-LOG2E * acc[nb][mb][2 * i]));
                  const float g1 = __builtin_amdgcn_rcpf(1.f + ex2(-LOG2E * acc[nb][mb][2 * i + 1]));
                  gq[i] = pk2(g0, g1);
                }
                uint4* gd = GT + ((wave * 4 + nb * 2 + mb) * 2) * 64 + lane;
                gd[0] = make_uint4(gq[0], gq[1], gq[2], gq[3]); gd[64] = make_uint4(gq[4], gq[5], gq[6], gq[7]);
              }
          } else {
#pragma unroll
            for (int nb = 0; nb < 2; ++nb)
#pragma unroll
              for (int mb = 0; mb < 2; ++mb) {
                const uint4* gd = GT + ((wave * 4 + nb * 2 + mb) * 2) * 64 + lane;
                const uint4 ga_ = gd[0], gb_ = gd[64];
                const unsigned gq[8] = {ga_.x, ga_.y, ga_.z, ga_.w, gb_.x, gb_.y, gb_.z, gb_.w};
#pragma unroll
                for (int i = 0; i < 8; ++i) {
                  mg[nb][mb][2 * i] += bflo(gq[i]) * acc[nb][mb][2 * i];
                  mg[nb][mb][2 * i + 1] += bfhi(gq[i]) * acc[nb][mb][2 * i + 1];
                }
              }
          }
        });
        {
          const int t__ = otid(); const int lane = t__ & 63, wave = t__ >> 6, wm = wave & 1, wn = wave >> 1;
          __syncthreads();
#pragma unroll
          for (int mb = 0; mb < 2; ++mb) {
            float o2[2][16];
#pragma unroll
            for (int nb = 0; nb < 2; ++nb)
#pragma unroll
              for (int i = 0; i < 16; ++i) o2[nb][i] = mg[nb][mb][i];
            wave_rows_bf16(lds_raw + wave * EPI_WAVE, o2, MG + (size_t)(wm * 64 + mb * 32) * DM + jt * 256 + wn * 64, DM, lane);
          }
        }
      }
      gemm_multi(MG, DM, w.WO, 1024, 1024, 4, lds, [&](f32x16 (&acc)[2][2], int jt, unsigned char* sl) {
          const int t__ = otid(); const int lane = t__ & 63, wave = t__ >> 6, wm = wave & 1, wn = wave >> 1, r = lane & 31, h = lane >> 5; (void)wm; (void)wn; (void)r; (void)h; (void)lane;
#pragma unroll
          for (int nb = 0; nb < 2; ++nb)
#pragma unroll
            for (int mb = 0; mb < 2; ++mb) {
              const size_t ro = (size_t)(wm * 64 + mb * 32) * DM + jt * 256 + wn * 64 + nb * 32;
              if (layer == 0) wave_rows_res<1, 0>(sl, acc[nb][mb], xin + ro, xt + ro, 0, lane);
              else wave_rows_res<0, 0>(sl, acc[nb][mb], xt + ro, xt + ro, 0, lane);
            }
        });
      __syncthreads();
      rmsnorm_tile_b(xt, p.ln2_g + layer * DM, Ht);
      for (int c = 0; c < 2; ++c) {
        gemm_multi(Ht, DM, w.W1 + (size_t)(c * 2048) * 1024, 1024, 1024, 8, lds, [&](f32x16 (&acc)[2][2], int jt, unsigned char* sl) {
            const int t__ = otid(); const int lane = t__ & 63, wave = t__ >> 6, wm = wave & 1, wn = wave >> 1;
#pragma unroll
            for (int mb = 0; mb < 2; ++mb) {
              float o2[2][16];
#pragma unroll
              for (int nb = 0; nb < 2; ++nb)
#pragma unroll
                for (int i = 0; i < 16; ++i) { const float v = fmaxf(acc[nb][mb][i], 0.f); o2[nb][i] = v * v; }
              wave_rows_bf16(sl, o2, MG + (size_t)(wm * 64 + mb * 32) * 2048 + jt * 256 + wn * 64, 2048, lane);
            }
          });
        gemm_multi(MG, 2048, w.W2 + c * 2048, 4096, 2048, 4, lds, [&](f32x16 (&acc)[2][2], int jt, unsigned char* sl) {
            const int t__ = otid(); const int lane = t__ & 63, wave = t__ >> 6, wm = wave & 1, wn = wave >> 1;
#pragma unroll
            for (int nb = 0; nb < 2; ++nb)
#pragma unroll
              for (int mb = 0; mb < 2; ++mb) {
                const size_t ro = (size_t)(wm * 64 + mb * 32) * DM + jt * 256 + wn * 64 + nb * 32;
                if (layer == DEPTH - 1 && c == 1) {
                  const size_t so = (jt == 0) ? OFF_QA : (jt == 1) ? OFF_QB : (jt == 2) ? OFF_KB : OFF_QCN;
                  float* d = (float*)(segw + so) + (size_t)(wm * 64 + mb * 32) * 256 + wn * 64 + nb * 32;
                  wave_rows_res<0, 1>(sl, acc[nb][mb], xt + ro, d, 256, lane);
                } else wave_rows_res<0, 0>(sl, acc[nb][mb], xt + ro, xt + ro, 0, lane);
              }
          });
      }
    }
  }
  grid.sync();
  for (int tile = blockIdx.x; tile < NT / 128; tile += G) {
    const int tok0 = tile * 128;
    final_norm(p.ws + (size_t)tok0 * 1024, p.final_g, p.out + (size_t)tok0 * DM);
  }
}

extern "C" void kernel_launch(void* const* d_in, const int* in_sizes, int n_in, void* d_out, int out_size, void* d_ws, size_t ws_size,
                              hipStream_t stream) {
  static int grid_blocks = 0;
  if (!grid_blocks) {
    int dev = 0, cus = 0, per_cu = 0;
    hipGetDevice(&dev);
    hipDeviceGetAttribute(&cus, hipDeviceAttributeMultiprocessorCount, dev);
    hipFuncSetAttribute((const void*)fwd_kernel, hipFuncAttributeMaxDynamicSharedMemorySize, LDS_BYTES);
    hipOccupancyMaxActiveBlocksPerMultiprocessor(&per_cu, (const void*)fwd_kernel, 512, LDS_BYTES);
    if (per_cu < 1) per_cu = 1;
    grid_blocks = cus * per_cu;
    if (grid_blocks > 256) grid_blocks = 256;
    if (ws_size < WS_END) fprintf(stderr, "workspace too small: %zu < %zu\n", ws_size, (size_t)WS_END);
  }
  Params p{};
  p.x = (const float*)d_in[0]; p.ln1_g = (const float*)d_in[1]; p.w_in = (const float*)d_in[2];
  p.a_q_norm = (const float*)d_in[3]; p.a_k_norm = (const float*)d_in[4]; p.b_lambda = (const float*)d_in[5];
  p.b_subln = (const float*)d_in[6]; p.c_q_norm = (const float*)d_in[7]; p.c_kv_norm = (const float*)d_in[8];
  p.c_w_uq = (const float*)d_in[9]; p.c_w_ukv = (const float*)d_in[10]; p.w_branch = (const float*)d_in[11];
  p.w_out = (const float*)d_in[12]; p.ln2_g = (const float*)d_in[13]; p.w_ff1 = (const float*)d_in[14];
  p.w_ff2 = (const float*)d_in[15]; p.final_g = (const float*)d_in[16];
  p.out = (float*)d_out; p.ws = (unsigned char*)d_ws;
  p.lam_init[0] = 0.2f;
  p.lam_init[1] = 0.35550906759f;
  p.lam_init[2] = 0.47071301834f;
  p.lam_init[3] = 0.55605820416f;
  void* args[] = {&p};
  hipError_t e = hipLaunchCooperativeKernel((const void*)fwd_kernel, dim3(grid_blocks), dim3(512), args, LDS_BYTES, stream);
  if (e != hipSuccess) fprintf(stderr, "cooperative launch failed: %s (grid %d)\n", hipGetErrorString(e), grid_blocks);
}
```

```cpp
#include <hip/hip_runtime.h>
#include <hip/hip_cooperative_groups.h>
#include <cstdio>
namespace cg = cooperative_groups;

#define DI __device__ __forceinline__
typedef unsigned short bf16_t;
typedef __attribute__((ext_vector_type(8))) short bf16x8;
typedef __attribute__((ext_vector_type(4))) short s16x4;
typedef __attribute__((ext_vector_type(16))) float f32x16;
#define MFMA(a, b, c) __builtin_amdgcn_mfma_f32_32x32x16_bf16((a), (b), (c), 0, 0, 0)

constexpr int NT = 32768;
constexpr int SEQ = 2048;
constexpr int DM = 1024;
constexpr int INC = 6048;
constexpr int NP1 = 2976;
constexpr int DEPTH = 4;
constexpr float LOG2E = 1.4426950408889634f;
constexpr float EPS = 1e-6f;

constexpr size_t SZ_T = (size_t)NT * 2;
constexpr size_t OFF_QA = 0;
constexpr size_t OFF_KA = OFF_QA + SZ_T * 512;
constexpr size_t OFF_VAT = OFF_KA + SZ_T * 128;
constexpr size_t OFF_QB = OFF_VAT + SZ_T * 128;
constexpr size_t OFF_KB = OFF_QB + SZ_T * 512;
constexpr size_t OFF_VBT = OFF_KB + SZ_T * 512;
constexpr size_t OFF_QCN = OFF_VBT + SZ_T * 512;
constexpr size_t OFF_QCR = OFF_QCN + SZ_T * 512;
constexpr size_t OFF_KCN = OFF_QCR + SZ_T * 256;
constexpr size_t OFF_KR = OFF_KCN + SZ_T * 512;
constexpr size_t OFF_VCT = OFF_KR + SZ_T * 32;
constexpr size_t OFF_H = OFF_VCT + SZ_T * 512;
constexpr size_t OFF_T2 = OFF_H + SZ_T * 1024;
constexpr size_t OFF_WP1 = OFF_T2 + SZ_T * 2048;
constexpr size_t OFF_WUQ = OFF_WP1 + (size_t)3072 * 1024 * 2;
constexpr size_t OFF_WUKV = OFF_WUQ + (size_t)768 * 384 * 2;
constexpr size_t OFF_WG = OFF_WUKV + (size_t)1024 * 256 * 2;
constexpr size_t OFF_WB = OFF_WG + (size_t)3072 * 1024 * 2;
constexpr size_t OFF_WO = OFF_WB + (size_t)3 * 1024 * 512 * 2;
constexpr size_t OFF_W1 = OFF_WO + (size_t)1024 * 1024 * 2;
constexpr size_t OFF_W2 = OFF_W1 + (size_t)4096 * 1024 * 2;
constexpr size_t OFF_TABC = OFF_W2 + (size_t)4096 * 1024 * 2;
constexpr size_t OFF_TABB = OFF_TABC + (size_t)2048 * 16 * 8;
constexpr size_t OFF_LAM = OFF_TABB + (size_t)2048 * 4 * 8;
constexpr size_t WS_END = OFF_LAM + 64;

constexpr int STG_A = 128 * 128;
constexpr int STG_B = 256 * 128;
constexpr int STG = STG_A + STG_B;
constexpr int NSTG = 3;
constexpr int LDS_GEMM_BYTES = NSTG * STG;
constexpr int LDS_RSTD_OFF = LDS_GEMM_BYTES;
constexpr int LDS_SSQ_OFF = LDS_GEMM_BYTES + 1024;
constexpr int LDS_BYTES = LDS_GEMM_BYTES + 1024 + 5120;
constexpr int KST = 64 * 104;
constexpr int VROW = 72;
constexpr int VST = 64 * VROW;
constexpr int AT_STAGE = KST + VST;
#define WAIT_VM(n) asm volatile("s_waitcnt vmcnt(" #n ")" ::: "memory")
#define RAW_BARRIER() asm volatile("s_waitcnt lgkmcnt(0)\n\ts_barrier" ::: "memory")

struct Params {
  const float* x; const float* ln1_g; const float* w_in; const float* a_q_norm; const float* a_k_norm;
  const float* b_lambda; const float* b_subln; const float* c_q_norm; const float* c_kv_norm;
  const float* c_w_uq; const float* c_w_ukv; const float* w_branch; const float* w_out; const float* ln2_g;
  const float* w_ff1; const float* w_ff2; const float* final_g;
  float* out; unsigned char* ws;
  float lam_init[4];
};

DI unsigned pk2(float a, float b) {
  typedef __attribute__((ext_vector_type(2))) __bf16 bf2;
  bf2 v = {(__bf16)a, (__bf16)b};
  return __builtin_bit_cast(unsigned, v);
}
DI bf16_t f2bf(float a) { return (bf16_t)(pk2(a, 0.f) & 0xffffu); }
DI float bf2f(unsigned v) { return __uint_as_float(v << 16); }
DI float bflo(unsigned v) { return __uint_as_float(v << 16); }
DI float bfhi(unsigned v) { return __uint_as_float(v & 0xffff0000u); }
DI float xh_max(float v) { auto r = __builtin_amdgcn_permlane32_swap(__float_as_uint(v), __float_as_uint(v), false, false); return fmaxf(__uint_as_float(r[0]), __uint_as_float(r[1])); }
DI float xh_sum(float v) { auto r = __builtin_amdgcn_permlane32_swap(__float_as_uint(v), __float_as_uint(v), false, false); return __uint_as_float(r[0]) + __uint_as_float(r[1]); }
DI float xh_other(float v, int h) { auto r = __builtin_amdgcn_permlane32_swap(__float_as_uint(v), __float_as_uint(v), false, false); return __uint_as_float(h ? r[0] : r[1]); }
DI float ex2(float v) { return __builtin_amdgcn_exp2f(v); }
DI int crow(int i, int h) { return (i & 3) + 8 * (i >> 2) + 4 * h; }
DI int otid() { int t = threadIdx.x; asm volatile("" : "+v"(t)); return t; }

DI void store16(bf16_t* dst, const float* o, int h) {
#pragma unroll
  for (int g = 0; g < 4; ++g) {
    uint2 v; v.x = pk2(o[4 * g], o[4 * g + 1]); v.y = pk2(o[4 * g + 2], o[4 * g + 3]);
    *(uint2*)(dst + 8 * g + 4 * h) = v;
  }
}
DI void store16v(bf16_t* dst, const f32x16& o, float sc, int h) {
#pragma unroll
  for (int g = 0; g < 4; ++g) {
    uint2 v; v.x = pk2(o[4 * g] * sc, o[4 * g + 1] * sc); v.y = pk2(o[4 * g + 2] * sc, o[4 * g + 3] * sc);
    *(uint2*)(dst + 8 * g + 4 * h) = v;
  }
}
DI void store16T(bf16_t* dst, const f32x16& o, float sc, int h) {
#pragma unroll
  for (int i = 0; i < 16; ++i) dst[(size_t)crow(i, h) * SEQ] = f2bf(o[i] * sc);
}
DI int vperm(int s) { return (s & ~12) | ((s & 4) << 1) | ((s & 8) >> 1); }

constexpr int EPI_ROWB = 144;
constexpr int EPI_WAVE = 32 * EPI_ROWB;
DI void wave_rows_bf16(unsigned char* lw, const float (&o)[2][16], bf16_t* dst0, int row_stride, int lane) {
  const int r = lane & 31, h = lane >> 5;
#pragma unroll
  for (int nb = 0; nb < 2; ++nb)
#pragma unroll
    for (int g = 0; g < 4; ++g) {
      uint2 v; v.x = pk2(o[nb][4 * g], o[nb][4 * g + 1]); v.y = pk2(o[nb][4 * g + 2], o[nb][4 * g + 3]);
      *(uint2*)(lw + r * EPI_ROWB + (nb * 32 + 8 * g + 4 * h) * 2) = v;
    }
#pragma unroll
  for (int it = 0; it < 4; ++it) {
    const int id = it * 64 + lane, row = id >> 3, c = id & 7;
    const uint4 v = *(const uint4*)(lw + row * EPI_ROWB + c * 16);
    *(uint4*)(dst0 + (size_t)row * row_stride + c * 8) = v;
  }
  asm volatile("" ::: "memory");
}
DI void wave_rows_rmw_f32(unsigned char* lw, const f32x16& a, const float* src0, float* dst0, int lane) {
  const int r = lane & 31, h = lane >> 5;
  float4 xv[4];
#pragma unroll
  for (int it = 0; it < 4; ++it) { const int id = it * 64 + lane; xv[it] = *(const float4*)(src0 + (size_t)(id >> 3) * DM + (id & 7) * 4); }
#pragma unroll
  for (int g = 0; g < 4; ++g) {
    float4 v = {a[4 * g], a[4 * g + 1], a[4 * g + 2], a[4 * g + 3]};
    *(float4*)(lw + r * EPI_ROWB + (8 * g + 4 * h) * 4) = v;
  }
#pragma unroll
  for (int it = 0; it < 4; ++it) {
    const int id = it * 64 + lane, row = id >> 3, c = id & 7;
    const float4 v = *(const float4*)(lw + row * EPI_ROWB + c * 16);
    float4 x = xv[it]; x.x += v.x; x.y += v.y; x.z += v.z; x.w += v.w;
    *(float4*)(dst0 + (size_t)row * DM + c * 4) = x;
  }
  asm volatile("" ::: "memory");
}

typedef _Float16 hf2 __attribute__((ext_vector_type(2)));
DI unsigned pkh2(float a, float b) { hf2 v = {(_Float16)a, (_Float16)b}; return __builtin_bit_cast(unsigned, v); }
DI float hlo(unsigned u) { return (float)__builtin_bit_cast(hf2, u)[0]; }
DI float hhi(unsigned u) { return (float)__builtin_bit_cast(hf2, u)[1]; }
template <int SRCF, int DSTF>
DI void wave_rows_res(unsigned char* lw, const f32x16& a, const void* src0, void* dst0, int dstride, int lane) {
  const int r = lane & 31, h = lane >> 5;
  float4 xv[4];
#pragma unroll
  for (int it = 0; it < 4; ++it) {
    const int id = it * 64 + lane; const size_t off = (size_t)(id >> 3) * DM + (id & 7) * 4;
    if (SRCF) xv[it] = *(const float4*)((const float*)src0 + off);
    else { const uint2 u = *(const uint2*)((const bf16_t*)src0 + off); xv[it] = make_float4(hlo(u.x), hhi(u.x), hlo(u.y), hhi(u.y)); }
  }
#pragma unroll
  for (int g = 0; g < 4; ++g) {
    float4 v = {a[4 * g], a[4 * g + 1], a[4 * g + 2], a[4 * g + 3]};
    *(float4*)(lw + r * EPI_ROWB + (8 * g + 4 * h) * 4) = v;
  }
#pragma unroll
  for (int it = 0; it < 4; ++it) {
    const int id = it * 64 + lane, row = id >> 3, c = id & 7;
    const float4 v = *(const float4*)(lw + row * EPI_ROWB + c * 16);
    float4 x = xv[it]; x.x += v.x; x.y += v.y; x.z += v.z; x.w += v.w;
    if (DSTF) *(float4*)((float*)dst0 + (size_t)row * dstride + c * 4) = x;
    else { uint2 o; o.x = pkh2(x.x, x.y); o.y = pkh2(x.z, x.w); *(uint2*)((bf16_t*)dst0 + (size_t)row * DM + c * 4) = o; }
  }
  asm volatile("" ::: "memory");
}
DI void rmsnorm_tile_b(const bf16_t* x, const float* __restrict__ g, bf16_t* __restrict__ dst) {
  const int tid_ = otid();
  const int lane = tid_ & 63, wave = tid_ >> 6;
  float4 gg[4];
#pragma unroll
  for (int j = 0; j < 4; ++j) gg[j] = *(const float4*)(g + j * 256 + lane * 4);
#pragma unroll 1
  for (int r0 = wave * 16; r0 < wave * 16 + 16; r0 += 8) {
    uint2 u[8][4];
#pragma unroll
    for (int q = 0; q < 8; ++q)
#pragma unroll
      for (int j = 0; j < 4; ++j) u[q][j] = *(const uint2*)(x + (size_t)(r0 + q) * DM + j * 256 + lane * 4);
#pragma unroll
    for (int q = 0; q < 8; ++q) {
      float4 v[4];
      float ss = 0.f;
#pragma unroll
      for (int j = 0; j < 4; ++j) { v[j] = make_float4(hlo(u[q][j].x), hhi(u[q][j].x), hlo(u[q][j].y), hhi(u[q][j].y)); ss += v[j].x * v[j].x + v[j].y * v[j].y + v[j].z * v[j].z + v[j].w * v[j].w; }
#pragma unroll
      for (int o = 32; o >= 1; o >>= 1) ss += __shfl_xor(ss, o);
      const float rs = rsqrtf(ss * (1.f / 1024.f) + EPS);
#pragma unroll
      for (int j = 0; j < 4; ++j) {
        uint2 o2; o2.x = pk2(v[j].x * rs * gg[j].x, v[j].y * rs * gg[j].y); o2.y = pk2(v[j].z * rs * gg[j].z, v[j].w * rs * gg[j].w);
        *(uint2*)(dst + (size_t)(r0 + q) * DM + j * 256 + lane * 4) = o2;
      }
    }
  }
}
DI void final_norm(const unsigned char* segws, const float* __restrict__ g, float* __restrict__ out) {
  const int tid_ = otid();
  const int lane = tid_ & 63, wave = tid_ >> 6;
  const float* sg[4] = {(const float*)(segws + OFF_QA), (const float*)(segws + OFF_QB), (const float*)(segws + OFF_KB), (const float*)(segws + OFF_QCN)};
  float4 gg[4];
#pragma unroll
  for (int j = 0; j < 4; ++j) gg[j] = *(const float4*)(g + j * 256 + lane * 4);
#pragma unroll 1
  for (int r0 = wave * 16; r0 < wave * 16 + 16; r0 += 4) {
    float4 v[4][4];
#pragma unroll
    for (int q = 0; q < 4; ++q)
#pragma unroll
      for (int j = 0; j < 4; ++j) v[q][j] = *(const float4*)(sg[j] + (size_t)(r0 + q) * 256 + lane * 4);
#pragma unroll
    for (int q = 0; q < 4; ++q) {
      float ss = 0.f;
#pragma unroll
      for (int j = 0; j < 4; ++j) ss += v[q][j].x * v[q][j].x + v[q][j].y * v[q][j].y + v[q][j].z * v[q][j].z + v[q][j].w * v[q][j].w;
#pragma unroll
      for (int o = 32; o >= 1; o >>= 1) ss += __shfl_xor(ss, o);
      const float rs = rsqrtf(ss * (1.f / 1024.f) + EPS);
#pragma unroll
      for (int j = 0; j < 4; ++j) {
        float4 o4 = {v[q][j].x * rs * gg[j].x, v[q][j].y * rs * gg[j].y, v[q][j].z * rs * gg[j].z, v[q][j].w * rs * gg[j].w};
        *(float4*)(out + (size_t)(r0 + q) * DM + j * 256 + lane * 4) = o4;
      }
    }
  }
}

DI void convert_T(const float* __restrict__ src, int ld_src, int K, int N, bf16_t* __restrict__ dst, int ld_dst,
                  const float* __restrict__ g, float* ldsf) {
  const int tid = otid();
  const int ntn = (N + 63) >> 6, ntk = K >> 6;
  const int nt = ntn * ntk;
  const int n4 = (tid & 15) * 4, kb = tid >> 4;
  float4 v[2];
  auto load_tile = [&](int t, float4 (&o)[2]) {
    const int k0 = (t / ntn) * 64, n0 = (t % ntn) * 64;
    const bool ok = (n0 + n4) < N;
#pragma unroll
    for (int i = 0; i < 2; ++i) {
      const int k = kb + 32 * i;
      float4 x = ok ? *(const float4*)(src + (size_t)(k0 + k) * ld_src + n0 + n4) : make_float4(0.f, 0.f, 0.f, 0.f);
      if (g) { const float gg = g[k0 + k]; x.x *= gg; x.y *= gg; x.z *= gg; x.w *= gg; }
      o[i] = x;
    }
  };
  int t = blockIdx.x;
  const int G_ = gridDim.x;
  float4 w1[2] = {make_float4(0.f, 0.f, 0.f, 0.f), make_float4(0.f, 0.f, 0.f, 0.f)};
  if (t < nt) load_tile(t, v);
  if (t + G_ < nt) load_tile(t + G_, w1);
  for (; t < nt; t += G_) {
    const int k0 = (t / ntn) * 64, n0 = (t % ntn) * 64;
    float4 nv[2] = {make_float4(0.f, 0.f, 0.f, 0.f), make_float4(0.f, 0.f, 0.f, 0.f)};
    const int tn = t + 2 * G_;
    if (tn < nt) load_tile(tn, nv);
    __syncthreads();
#pragma unroll
    for (int i = 0; i < 2; ++i) {
      const int k = kb + 32 * i;
      ldsf[(n4 + 0) * 65 + k] = v[i].x; ldsf[(n4 + 1) * 65 + k] = v[i].y; ldsf[(n4 + 2) * 65 + k] = v[i].z; ldsf[(n4 + 3) * 65 + k] = v[i].w;
    }
    __syncthreads();
    {
      const int n2 = tid >> 3, c = (tid & 7) * 8;
      if (n0 + n2 < N) {
        const float* sp = ldsf + n2 * 65 + c;
        uint4 o; o.x = pk2(sp[0], sp[1]); o.y = pk2(sp[2], sp[3]); o.z = pk2(sp[4], sp[5]); o.w = pk2(sp[6], sp[7]);
        *(uint4*)(dst + (size_t)(n0 + n2) * ld_dst + k0 + c) = o;
      }
    }
    v[0] = w1[0]; v[1] = w1[1]; w1[0] = nv[0]; w1[1] = nv[1];
  }
}

template <bool F32OUT>
DI void rmsnorm_tile(const float* x, const float* __restrict__ g, bf16_t* __restrict__ dst, float* dstf) {
  const int tid_ = otid();
  const int lane = tid_ & 63, wave = tid_ >> 6;
  float4 gg[4];
#pragma unroll
  for (int j = 0; j < 4; ++j) gg[j] = *(const float4*)(g + j * 256 + lane * 4);
#pragma unroll 1
  for (int r0 = wave * 16; r0 < wave * 16 + 16; r0 += 4) {
    float4 v[4][4];
#pragma unroll
    for (int q = 0; q < 4; ++q)
#pragma unroll
      for (int j = 0; j < 4; ++j) v[q][j] = *(const float4*)(x + (size_t)(r0 + q) * DM + j * 256 + lane * 4);
#pragma unroll
    for (int q = 0; q < 4; ++q) {
      float ss = 0.f;
#pragma unroll
      for (int j = 0; j < 4; ++j) ss += v[q][j].x * v[q][j].x + v[q][j].y * v[q][j].y + v[q][j].z * v[q][j].z + v[q][j].w * v[q][j].w;
#pragma unroll
      for (int o = 32; o >= 1; o >>= 1) ss += __shfl_xor(ss, o);
      const float rs = rsqrtf(ss * (1.f / 1024.f) + EPS);
#pragma unroll
      for (int j = 0; j < 4; ++j) {
        const float a = v[q][j].x * rs * gg[j].x, b = v[q][j].y * rs * gg[j].y, c = v[q][j].z * rs * gg[j].z, d = v[q][j].w * rs * gg[j].w;
        if (F32OUT) {
          float4 o4 = {a, b, c, d};
          *(float4*)(dstf + (size_t)(r0 + q) * DM + j * 256 + lane * 4) = o4;
        } else {
          uint2 o2; o2.x = pk2(a, b); o2.y = pk2(c, d);
          *(uint2*)(dst + (size_t)(r0 + q) * DM + j * 256 + lane * 4) = o2;
        }
      }
    }
  }
}

template <class Epi>
DI void gemm_tile(const bf16_t* __restrict__ A, int lda, const bf16_t* __restrict__ Bt, int ldb, int K, bf16_t* lds_, Epi epi) {
  unsigned char* lds = (unsigned char*)lds_;
  const int tid = otid(), lane = tid & 63, wave = tid >> 6;
  const int wm = wave & 1, wn = wave >> 1, r = lane & 31, h = lane >> 5;
  const int lr = lane >> 3, lcp = lane & 7;
  const bf16_t* pa[2]; const bf16_t* pb[4];
#pragma unroll
  for (int i = 0; i < 2; ++i) { const int row = (wave * 2 + i) * 8 + lr; pa[i] = A + (size_t)row * lda + ((lcp ^ ((row >> 1) & 7)) * 8); }
#pragma unroll
  for (int i = 0; i < 4; ++i) { const int row = (wave * 4 + i) * 8 + lr; pb[i] = Bt + (size_t)row * ldb + ((lcp ^ ((row >> 1) & 7)) * 8); }
  f32x16 acc[2][2];
#pragma unroll
  for (int nb = 0; nb < 2; ++nb)
#pragma unroll
    for (int mb = 0; mb < 2; ++mb)
#pragma unroll
      for (int i = 0; i < 16; ++i) acc[nb][mb][i] = 0.f;
  const int x = h ^ ((r >> 1) & 7);
  int co[4];
#pragma unroll
  for (int st = 0; st < 4; ++st) co[st] = (x ^ (2 * st)) << 4;
  const int arow = (wm * 64 + r) * 128;
  const int brow = STG_A + (wn * 64 + r) * 128;
  auto issue_part = [&](int kt, int sidx, int part) {
    unsigned char* sa = lds + sidx * STG; unsigned char* sb = sa + STG_A;
    if (part == 0) {
#pragma unroll
      for (int i = 0; i < 2; ++i)
        __builtin_amdgcn_global_load_lds((const unsigned*)(pa[i] + kt * 64), (unsigned*)(sa + (wave * 2 + i) * 1024), 16, 0, 0);
    } else {
#pragma unroll
      for (int i = 2 * (part - 1); i < 2 * part; ++i)
        __builtin_amdgcn_global_load_lds((const unsigned*)(pb[i] + kt * 64), (unsigned*)(sb + (wave * 4 + i) * 1024), 16, 0, 0);
    }
  };
  auto issue = [&](int kt, int sidx) { issue_part(kt, sidx, 0); issue_part(kt, sidx, 1); issue_part(kt, sidx, 2); };
  const int nk = K >> 6;
  WAIT_VM(0);
  RAW_BARRIER();
  issue(0, 0); issue(1, 1);
  int sc = 0, sn = 2;
#pragma unroll 1
  for (int j = 0; j < nk; ++j) {
    if (j + 1 < nk) WAIT_VM(6); else WAIT_VM(0);
    RAW_BARRIER();
    const bool pre = (j + 2) < nk;
    const unsigned char* base = lds + sc * STG;
#pragma unroll
    for (int st = 0; st < 4; ++st) {
      const bf16x8 af0 = *(const bf16x8*)(base + arow + co[st]);
      const bf16x8 af1 = *(const bf16x8*)(base + arow + 4096 + co[st]);
      const bf16x8 bf0 = *(const bf16x8*)(base + brow + co[st]);
      const bf16x8 bf1 = *(const bf16x8*)(base + brow + 4096 + co[st]);
      acc[0][0] = MFMA(bf0, af0, acc[0][0]);
      acc[0][1] = MFMA(bf0, af1, acc[0][1]);
      acc[1][0] = MFMA(bf1, af0, acc[1][0]);
      acc[1][1] = MFMA(bf1, af1, acc[1][1]);
      if (st < 3 && pre) issue_part(j + 2, sn, st);
    }
    sc = (sc == 2) ? 0 : sc + 1; sn = (sn == 2) ? 0 : sn + 1;
  }
  epi(acc);
}

template <class Epi>
DI void gemm_multi(const bf16_t* __restrict__ A, int lda, const bf16_t* __restrict__ Bt, int ldb, int K, int ntiles, bf16_t* lds_, Epi epi) {
  unsigned char* lds = (unsigned char*)lds_;
  const int tid = otid(), lane = tid & 63, wave = tid >> 6;
  const int wm = wave & 1, wn = wave >> 1, r = lane & 31, h = lane >> 5;
  const int lr = lane >> 3, lcp = lane & 7;
  const bf16_t* pa[2]; const bf16_t* pb[4];
#pragma unroll
  for (int i = 0; i < 2; ++i) { const int row = (wave * 2 + i) * 8 + lr; pa[i] = A + (size_t)row * lda + ((lcp ^ ((row >> 1) & 7)) * 8); }
#pragma unroll
  for (int i = 0; i < 4; ++i) { const int row = (wave * 4 + i) * 8 + lr; pb[i] = Bt + (size_t)row * ldb + ((lcp ^ ((row >> 1) & 7)) * 8); }
  f32x16 acc[2][2];
#pragma unroll
  for (int nb = 0; nb < 2; ++nb)
#pragma unroll
    for (int mb = 0; mb < 2; ++mb)
#pragma unroll
      for (int i = 0; i < 16; ++i) acc[nb][mb][i] = 0.f;
  const int x = h ^ ((r >> 1) & 7);
  int co[4];
#pragma unroll
  for (int st = 0; st < 4; ++st) co[st] = (x ^ (2 * st)) << 4;
  const int arow = (wm * 64 + r) * 128;
  const int brow = STG_A + (wn * 64 + r) * 128;
  int pkt = 0; size_t pboff = 0;
  auto issue_part = [&](int sidx, int part) {
    unsigned char* sa = lds + sidx * STG; unsigned char* sb = sa + STG_A;
    if (part == 0) {
#pragma unroll
      for (int i = 0; i < 2; ++i)
        __builtin_amdgcn_global_load_lds((const unsigned*)(pa[i] + pkt * 64), (unsigned*)(sa + (wave * 2 + i) * 1024), 16, 0, 0);
    } else {
#pragma unroll
      for (int i = 2 * (part - 1); i < 2 * part; ++i)
        __builtin_amdgcn_global_load_lds((const unsigned*)(pb[i] + pboff + pkt * 64), (unsigned*)(sb + (wave * 4 + i) * 1024), 16, 0, 0);
    }
  };
  const int nk = K >> 6, total = ntiles * nk;
  const size_t bstep = (size_t)256 * ldb;
  WAIT_VM(0);
  RAW_BARRIER();
  issue_part(0, 0); issue_part(0, 1); issue_part(0, 2);
  if (++pkt == nk) { pkt = 0; pboff += bstep; }
  issue_part(1, 0); issue_part(1, 1); issue_part(1, 2);
  if (++pkt == nk) { pkt = 0; pboff += bstep; }
  int sc = 0, sn = 2, kt = 0, nt = 0;
#pragma unroll 1
  for (int j = 0; j < total; ++j) {
    if (j + 1 < total) WAIT_VM(6); else WAIT_VM(0);
    RAW_BARRIER();
    const bool pre = (j + 2) < total;
    const unsigned char* base = lds + sc * STG;
    bf16x8 fa[2][2], fb[2][2];
    fa[0][0] = *(const bf16x8*)(base + arow + co[0]);
    fa[0][1] = *(const bf16x8*)(base + arow + 4096 + co[0]);
    fb[0][0] = *(const bf16x8*)(base + brow + co[0]);
    fb[0][1] = *(const bf16x8*)(base + brow + 4096 + co[0]);
#pragma unroll
    for (int st = 0; st < 4; ++st) {
      const int cur = st & 1, nxt = cur ^ 1;
      if (st < 3) {
        fa[nxt][0] = *(const bf16x8*)(base + arow + co[st + 1]);
        fa[nxt][1] = *(const bf16x8*)(base + arow + 4096 + co[st + 1]);
        fb[nxt][0] = *(const bf16x8*)(base + brow + co[st + 1]);
        fb[nxt][1] = *(const bf16x8*)(base + brow + 4096 + co[st + 1]);
      }
      asm volatile("" : "+v"(fa[cur][0]), "+v"(fa[cur][1]), "+v"(fb[cur][0]), "+v"(fb[cur][1]) :: "memory");
      acc[0][0] = MFMA(fb[cur][0], fa[cur][0], acc[0][0]);
      acc[0][1] = MFMA(fb[cur][0], fa[cur][1], acc[0][1]);
      acc[1][0] = MFMA(fb[cur][1], fa[cur][0], acc[1][0]);
      acc[1][1] = MFMA(fb[cur][1], fa[cur][1], acc[1][1]);
      if (st < 3 && pre) issue_part(sn, st);
    }
    if (pre) { if (++pkt == nk) { pkt = 0; pboff += bstep; } }
    sc = (sc == 2) ? 0 : sc + 1; sn = (sn == 2) ? 0 : sn + 1;
    if (++kt == nk) {
      RAW_BARRIER();
      epi(acc, nt, lds + sn * STG + wave * EPI_WAVE);
#pragma unroll
      for (int nb = 0; nb < 2; ++nb)
#pragma unroll
        for (int mb = 0; mb < 2; ++mb)
#pragma unroll
          for (int i = 0; i < 16; ++i) acc[nb][mb][i] = 0.f;
      kt = 0; ++nt;
    }
  }
}

template <class Epi>
DI void gemm_merge(const bf16_t* __restrict__ Ht, const unsigned char* segws, const bf16_t* __restrict__ WGj, const bf16_t* __restrict__ WBj, bf16_t* lds_, Epi epi) {
  unsigned char* lds = (unsigned char*)lds_;
  const int tid = otid(), lane = tid & 63, wave = tid >> 6;
  const int wm = wave & 1, wn = wave >> 1, r = lane & 31, h = lane >> 5;
  const int lr = lane >> 3, lcp = lane & 7;
  int oa1[2], oa5[2], ob1[4], ob5[4];
#pragma unroll
  for (int i = 0; i < 2; ++i) { const int row = (wave * 2 + i) * 8 + lr; const int cs = (lcp ^ ((row >> 1) & 7)) * 8; oa1[i] = row * 1024 + cs; oa5[i] = row * 512 + cs; }
#pragma unroll
  for (int i = 0; i < 4; ++i) { const int row = (wave * 4 + i) * 8 + lr; const int cs = (lcp ^ ((row >> 1) & 7)) * 8; ob1[i] = row * 1024 + cs; ob5[i] = row * 512 + cs; }
  f32x16 acc[2][2];
#pragma unroll
  for (int nb = 0; nb < 2; ++nb)
#pragma unroll
    for (int mb = 0; mb < 2; ++mb)
#pragma unroll
      for (int i = 0; i < 16; ++i) acc[nb][mb][i] = 0.f;
  const int x = h ^ ((r >> 1) & 7);
  int co[4];
#pragma unroll
  for (int st = 0; st < 4; ++st) co[st] = (x ^ (2 * st)) << 4;
  const int arow = (wm * 64 + r) * 128;
  const int brow = STG_A + (wn * 64 + r) * 128;
  int pseg = 0, pkt = 0;
  auto issue_part = [&](int sidx, int part) {
    unsigned char* sa = lds + sidx * STG; unsigned char* sb = sa + STG_A;
    const int n = pseg >> 1; const bool gate = (pseg & 1) == 0;
    if (part == 0) {
      const size_t offy = (n == 0) ? OFF_QA : (n == 1) ? OFF_QB : OFF_QCN;
      const bf16_t* ab = gate ? Ht : (const bf16_t*)(segws + offy);
#pragma unroll
      for (int i = 0; i < 2; ++i)
        __builtin_amdgcn_global_load_lds((const unsigned*)(ab + (gate ? oa1[i] : oa5[i]) + pkt * 64), (unsigned*)(sa + (wave * 2 + i) * 1024), 16, 0, 0);
    } else {
      const bf16_t* bb = gate ? (WGj + (size_t)n * 1024 * 1024) : (WBj + (size_t)n * 1024 * 512);
#pragma unroll
      for (int i = 2 * (part - 1); i < 2 * part; ++i)
        __builtin_amdgcn_global_load_lds((const unsigned*)(bb + (gate ? ob1[i] : ob5[i]) + pkt * 64), (unsigned*)(sb + (wave * 4 + i) * 1024), 16, 0, 0);
    }
  };
  auto advance = [&]() { if (++pkt == ((pseg & 1) ? 8 : 16)) { pkt = 0; ++pseg; } };
  constexpr int total = 3 * (16 + 8);
  WAIT_VM(0);
  RAW_BARRIER();
  issue_part(0, 0); issue_part(0, 1); issue_part(0, 2); advance();
  issue_part(1, 0); issue_part(1, 1); issue_part(1, 2); advance();
  int sc = 0, sn = 2, kt = 0, cseg = 0;
#pragma unroll 1
  for (int j = 0; j < total; ++j) {
    if (j + 1 < total) WAIT_VM(6); else WAIT_VM(0);
    RAW_BARRIER();
    const bool pre = (j + 2) < total;
    const unsigned char* base = lds + sc * STG;
    bf16x8 fa[2][2], fb[2][2];
    fa[0][0] = *(const bf16x8*)(base + arow + co[0]);
    fa[0][1] = *(const bf16x8*)(base + arow + 4096 + co[0]);
    fb[0][0] = *(const bf16x8*)(base + brow + co[0]);
    fb[0][1] = *(const bf16x8*)(base + brow + 4096 + co[0]);
#pragma unroll
    for (int st = 0; st < 4; ++st) {
      const int cur = st & 1, nxt = cur ^ 1;
      if (st < 3) {
        fa[nxt][0] = *(const bf16x8*)(base + arow + co[st + 1]);
        fa[nxt][1] = *(const bf16x8*)(base + arow + 4096 + co[st + 1]);
        fb[nxt][0] = *(const bf16x8*)(base + brow + co[st + 1]);
        fb[nxt][1] = *(const bf16x8*)(base + brow + 4096 + co[st + 1]);
      }
      asm volatile("" : "+v"(fa[cur][0]), "+v"(fa[cur][1]), "+v"(fb[cur][0]), "+v"(fb[cur][1]) :: "memory");
      acc[0][0] = MFMA(fb[cur][0], fa[cur][0], acc[0][0]);
      acc[0][1] = MFMA(fb[cur][0], fa[cur][1], acc[0][1]);
      acc[1][0] = MFMA(fb[cur][1], fa[cur][0], acc[1][0]);
      acc[1][1] = MFMA(fb[cur][1], fa[cur][1], acc[1][1]);
      if (st < 3 && pre) issue_part(sn, st);
    }
    if (pre) advance();
    sc = (sc == 2) ? 0 : sc + 1; sn = (sn == 2) ? 0 : sn + 1;
    if (++kt == ((cseg & 1) ? 8 : 16)) {
      epi(acc, cseg);
#pragma unroll
      for (int nb = 0; nb < 2; ++nb)
#pragma unroll
        for (int mb = 0; mb < 2; ++mb)
#pragma unroll
          for (int i = 0; i < 16; ++i) acc[nb][mb][i] = 0.f;
      kt = 0; ++cseg;
    }
  }
}

DI void rot32(const f32x16& v, const float* mul, float sc, const float2* __restrict__ tab, int h, float* o) {
#pragma unroll
  for (int i = 0; i < 8; ++i) {
    const int j = crow(i, h);
    const float2 cs = tab[j];
    const float x1 = v[i] * sc * (mul ? mul[j] : 1.f), x2 = v[i + 8] * sc * (mul ? mul[j + 16] : 1.f);
    o[i] = x1 * cs.x - x2 * cs.y;
    o[i + 8] = x2 * cs.x + x1 * cs.y;
  }
}

struct WS {
  bf16_t *QA, *KA, *VAT, *QB, *KB, *VBT, *QCN, *QCR, *KCN, *KR, *VCT, *H, *T2;
  bf16_t *WP1, *WUQ, *WUKV, *WG, *WB, *WO, *W1, *W2;
  float2 *TABC, *TABB; float* LAM;
};
DI WS make_ws(unsigned char* ws) {
  WS w;
  w.QA = (bf16_t*)(ws + OFF_QA); w.KA = (bf16_t*)(ws + OFF_KA); w.VAT = (bf16_t*)(ws + OFF_VAT);
  w.QB = (bf16_t*)(ws + OFF_QB); w.KB = (bf16_t*)(ws + OFF_KB); w.VBT = (bf16_t*)(ws + OFF_VBT);
  w.QCN = (bf16_t*)(ws + OFF_QCN); w.QCR = (bf16_t*)(ws + OFF_QCR); w.KCN = (bf16_t*)(ws + OFF_KCN);
  w.KR = (bf16_t*)(ws + OFF_KR); w.VCT = (bf16_t*)(ws + OFF_VCT); w.H = (bf16_t*)(ws + OFF_H); w.T2 = (bf16_t*)(ws + OFF_T2);
  w.WP1 = (bf16_t*)(ws + OFF_WP1); w.WUQ = (bf16_t*)(ws + OFF_WUQ); w.WUKV = (bf16_t*)(ws + OFF_WUKV);
  w.WG = (bf16_t*)(ws + OFF_WG); w.WB = (bf16_t*)(ws + OFF_WB); w.WO = (bf16_t*)(ws + OFF_WO);
  w.W1 = (bf16_t*)(ws + OFF_W1); w.W2 = (bf16_t*)(ws + OFF_W2);
  w.TABC = (float2*)(ws + OFF_TABC); w.TABB = (float2*)(ws + OFF_TABB); w.LAM = (float*)(ws + OFF_LAM);
  return w;
}

DI void p1_epi(f32x16 (&acc)[2][2], int ntile, int tok0, const WS& w, const float* __restrict__ aqg, const float* __restrict__ akg, bf16_t* CQ, bf16_t* CKV, unsigned char* sl, float* ssq) {
  const int tid_ = otid();
  const int lane = tid_ & 63, wave = tid_ >> 6;
  const int wm = wave & 1, wn = wave >> 1, r = lane & 31, h = lane >> 5;
  const int c64 = ntile * 256 + wn * 64;
  if (c64 >= NP1) return;
#pragma unroll
  for (int mb = 0; mb < 2; ++mb) {
    const int tl = wm * 64 + mb * 32 + r;
    const int t = tok0 + tl;
    const int s = t & (SEQ - 1), b = t >> 11;
    float oc[2][16];
    if (c64 < 640) {
      const bool isq = c64 < 512;
      const float* g = isq ? aqg : akg;
      float ss = 0.f;
#pragma unroll
      for (int nb = 0; nb < 2; ++nb)
#pragma unroll
        for (int i = 0; i < 16; ++i) ss += acc[nb][mb][i] * acc[nb][mb][i];
      ss = xh_sum(ss);
      const float rs = rsqrtf(ss * (1.f / 64.f) + EPS) * (isq ? 0.125f * LOG2E : 1.f);
      const int t0 = tok0 + wm * 64 + mb * 32;
      bf16_t* dst0 = isq ? (w.QA + (size_t)t0 * 512 + c64) : (w.KA + (size_t)t0 * 128 + (c64 - 512));
      float o2[2][16];
#pragma unroll
      for (int nb = 0; nb < 2; ++nb) {
        const int pos = (nb == 0) ? (s >> 6) : (s & 63);
        rot32(acc[nb][mb], g + nb * 32, rs, w.TABC + pos * 16, h, o2[nb]);
      }
      wave_rows_bf16(sl, o2, dst0, isq ? 512 : 128, lane);
    } else if (c64 < 768) {
      const int kvh = (c64 - 640) >> 6;
#pragma unroll
      for (int nb = 0; nb < 2; ++nb)
        store16T(w.VAT + ((size_t)(b * 2 + kvh) * 64 + nb * 32) * SEQ + vperm(s), acc[nb][mb], 1.f, h);
    } else if (c64 < 1792) {
      const bool isq = c64 < 1280;
      const float sc = isq ? 0.17677669529663687f * LOG2E : 1.f;
      const int t0 = tok0 + wm * 64 + mb * 32;
      bf16_t* dst0 = isq ? (w.QB + (size_t)t0 * 512 + (c64 - 768)) : (w.KB + (size_t)t0 * 512 + (c64 - 1280));
      float o2[2][16];
#pragma unroll
      for (int nb = 0; nb < 2; ++nb) {
#pragma unroll
        for (int i = 0; i < 16; ++i) o2[nb][i] = acc[nb][mb][i] * sc;
#pragma unroll
        for (int i = 0; i < 4; ++i) {
          const float other = xh_other(o2[nb][i], h);
          const float2 cs = w.TABB[s * 4 + i];
          o2[nb][i] = h ? (o2[nb][i] * cs.x + other * cs.y) : (o2[nb][i] * cs.x - other * cs.y);
        }
      }
      wave_rows_bf16(sl, o2, dst0, 512, lane);
    } else if (c64 < 2304) {
      const int hd = (c64 - 1792) >> 6;
#pragma unroll
      for (int nb = 0; nb < 2; ++nb)
        store16T(w.VBT + ((size_t)(b * 8 + hd) * 64 + nb * 32) * SEQ + vperm(s), acc[nb][mb], 1.f, h);
    } else if (c64 < 2688) {
#pragma unroll
      for (int nb = 0; nb < 2; ++nb)
#pragma unroll
        for (int i = 0; i < 16; ++i) oc[nb][i] = acc[nb][mb][i];
      {
        float ss = 0.f;
#pragma unroll
        for (int nb = 0; nb < 2; ++nb)
#pragma unroll
          for (int i = 0; i < 16; ++i) ss += oc[nb][i] * oc[nb][i];
        ss = xh_sum(ss);
        if (h == 0) ssq[((c64 - 2304) >> 6) * 128 + tl] = ss;
      }
      wave_rows_bf16(sl, oc, CQ + (size_t)(wm * 64 + mb * 32) * 384 + (c64 - 2304), 384, lane);
    } else if (c64 < 2944) {
#pragma unroll
      for (int nb = 0; nb < 2; ++nb)
#pragma unroll
        for (int i = 0; i < 16; ++i) oc[nb][i] = acc[nb][mb][i];
      {
        float ss = 0.f;
#pragma unroll
        for (int nb = 0; nb < 2; ++nb)
#pragma unroll
          for (int i = 0; i < 16; ++i) ss += oc[nb][i] * oc[nb][i];
        ss = xh_sum(ss);
        if (h == 0) ssq[(6 + ((c64 - 2688) >> 6)) * 128 + tl] = ss;
      }
      wave_rows_bf16(sl, oc, CKV + (size_t)(wm * 64 + mb * 32) * 256 + (c64 - 2688), 256, lane);
    } else {
      float o[16];
      rot32(acc[0][mb], nullptr, 1.f, w.TABC + s * 16, h, o);
      store16(w.KR + (size_t)t * 32, o, h);
    }
  }
}

template <int DQK>
DI void flash(const bf16x8* qf, const bf16_t* __restrict__ K1, int ld1, const bf16_t* __restrict__ K2, int ld2,
              const bf16_t* __restrict__ Vt, bf16_t* lds, f32x16 (&ot)[2], float& lsum) {
  constexpr int KROW = DQK + 8, CPR = DQK / 8, NCH = 64 * CPR, NS = DQK / 16;
  const int tid = otid(), lane = tid & 63;
  const int r = lane & 31, h = lane >> 5;
  const int id0 = tid, id1 = tid + 512;
  const bool v0 = id0 < NCH, v1 = id1 < NCH;
  const int row0 = id0 / CPR, c0 = id0 % CPR, row1 = id1 / CPR, c1 = id1 % CPR;
  const bf16_t* kp0; size_t ks0;
  const bf16_t* kp1; size_t ks1;
  if (DQK == 96 && c0 >= 8) { kp0 = K2 + (size_t)row0 * ld2 + (c0 - 8) * 8; ks0 = (size_t)64 * ld2; }
  else { kp0 = K1 + (size_t)row0 * ld1 + c0 * 8; ks0 = (size_t)64 * ld1; }
  if (DQK == 96 && c1 >= 8) { kp1 = K2 + (size_t)row1 * ld2 + (c1 - 8) * 8; ks1 = (size_t)64 * ld2; }
  else { kp1 = K1 + (size_t)row1 * ld1 + c1 * 8; ks1 = (size_t)64 * ld1; }
  const int lk0 = row0 * KROW + c0 * 8, lk1 = row1 * KROW + c1 * 8;
  const int vd = tid >> 3, vc = (tid & 7) * 8;
  const bf16_t* vp = Vt + (size_t)vd * SEQ + vc;
  const int lv = vd * VROW + vc;
#pragma unroll
  for (int db = 0; db < 2; ++db)
#pragma unroll
    for (int i = 0; i < 16; ++i) ot[db][i] = 0.f;
  f32x16 NM;
#pragma unroll
  for (int i = 0; i < 16; ++i) NM[i] = 0.f;
  float lacc = 0.f;
  uint4 rk0 = {0, 0, 0, 0}, rk1 = {0, 0, 0, 0}, rv;
  __syncthreads();
  if (v0) rk0 = *(const uint4*)kp0;
  if (v1) rk1 = *(const uint4*)kp1;
  rv = *(const uint4*)vp;
  {
    bf16_t* sk = lds; bf16_t* sv = lds + KST;
    if (v0) *(uint4*)(sk + lk0) = rk0;
    if (v1) *(uint4*)(sk + lk1) = rk1;
    *(uint4*)(sv + lv) = rv;
  }
  __syncthreads();
  constexpr int NTILE = SEQ / 64;
#pragma unroll 1
  for (int kt = 0; kt < NTILE; ++kt) {
    const bf16_t* sk = lds + (kt & 1) * AT_STAGE; const bf16_t* sv = sk + KST;
    const bool more = (kt + 1) < NTILE;
    if (more) {
      if (v0) rk0 = *(const uint4*)(kp0 + (size_t)(kt + 1) * ks0);
      if (v1) rk1 = *(const uint4*)(kp1 + (size_t)(kt + 1) * ks1);
      rv = *(const uint4*)(vp + (kt + 1) * 64);
    }
    f32x16 st[2];
    bf16x8 kf[2][NS];
#pragma unroll
    for (int kb = 0; kb < 2; ++kb)
#pragma unroll
      for (int s = 0; s < NS; ++s) kf[kb][s] = *(const bf16x8*)(sk + (kb * 32 + r) * KROW + s * 16 + h * 8);
    __builtin_amdgcn_sched_barrier(0);
#pragma unroll
    for (int s = 0; s < NS; ++s)
#pragma unroll
      for (int kb = 0; kb < 2; ++kb) st[kb] = MFMA(kf[kb][s], qf[s], (s == 0) ? NM : st[kb]);
    bf16x8 vfr[2][2][2];
#pragma unroll
    for (int kb = 0; kb < 2; ++kb)
#pragma unroll
      for (int s = 0; s < 2; ++s)
#pragma unroll
        for (int db = 0; db < 2; ++db) vfr[kb][s][db] = *(const bf16x8*)(sv + (db * 32 + r) * VROW + kb * 32 + 16 * s + 8 * h);
    __builtin_amdgcn_sched_barrier(0);
    float mx = st[0][0];
#pragma unroll
    for (int i = 1; i < 16; ++i) mx = fmaxf(mx, st[0][i]);
#pragma unroll
    for (int i = 0; i < 16; ++i) mx = fmaxf(mx, st[1][i]);
    mx = xh_max(mx);
    if (kt == 0 || __any(mx > 8.f)) {
      const float d = (kt == 0) ? mx : fmaxf(mx, 0.f);
      const float alpha = ex2(-d);
#pragma unroll
      for (int kb = 0; kb < 2; ++kb)
#pragma unroll
        for (int i = 0; i < 16; ++i) st[kb][i] -= d;
#pragma unroll
      for (int i = 0; i < 16; ++i) NM[i] -= d;
      if (kt != 0) {
#pragma unroll
        for (int db = 0; db < 2; ++db)
#pragma unroll
          for (int i = 0; i < 16; ++i) ot[db][i] *= alpha;
        lacc *= alpha;
      }
    }
#pragma unroll
    for (int kb = 0; kb < 2; ++kb)
#pragma unroll
      for (int s = 0; s < 2; ++s) {
        typedef __attribute__((ext_vector_type(4))) unsigned u32x4;
        u32x4 pp;
#pragma unroll
        for (int e = 0; e < 4; ++e) {
          const float p0 = ex2(st[kb][8 * s + 2 * e]), p1 = ex2(st[kb][8 * s + 2 * e + 1]);
          lacc += p0 + p1;
          pp[e] = pk2(p0, p1);
        }
        const bf16x8 pf = __builtin_bit_cast(bf16x8, pp);
#pragma unroll
        for (int db = 0; db < 2; ++db) ot[db] = MFMA(vfr[kb][s][db], pf, ot[db]);
      }
    if (more) {
      bf16_t* nk_ = lds + ((kt + 1) & 1) * AT_STAGE; bf16_t* nv = nk_ + KST;
      if (v0) *(uint4*)(nk_ + lk0) = rk0;
      if (v1) *(uint4*)(nk_ + lk1) = rk1;
      *(uint4*)(nv + lv) = rv;
    }
    __syncthreads();
  }
  const float l = lacc;
  lsum = xh_sum(l);
}

DI void flash_b(const bf16x8* qf, const bf16_t* __restrict__ K1, int ld1, const bf16_t* __restrict__ Vt, bf16_t* lds,
                f32x16 (&ot)[2][2], float (&lsum)[2]) {
  constexpr int KROW = 72;
  const int tid = otid(), lane = tid & 63;
  const int r = lane & 31, h = lane >> 5;
  const int row0 = tid >> 3, c0 = tid & 7;
  const bf16_t* kp0 = K1 + (size_t)row0 * ld1 + c0 * 8; const size_t ks0 = (size_t)64 * ld1;
  const int lk0 = row0 * KROW + c0 * 8;
  const int vd = tid >> 3, vc = (tid & 7) * 8;
  const bf16_t* vp = Vt + (size_t)vd * SEQ + vc;
  const int lv = vd * VROW + vc;
  f32x16 NM[2];
  float lacc[2] = {0.f, 0.f};
#pragma unroll
  for (int c = 0; c < 2; ++c) {
#pragma unroll
    for (int i = 0; i < 16; ++i) { NM[c][i] = 0.f; ot[c][0][i] = 0.f; ot[c][1][i] = 0.f; }
  }
  uint4 rk0, rv;
  __syncthreads();
  rk0 = *(const uint4*)kp0;
  rv = *(const uint4*)vp;
  *(uint4*)(lds + lk0) = rk0;
  *(uint4*)(lds + KST + lv) = rv;
  __syncthreads();
  constexpr int NTILE = SEQ / 64;
#pragma unroll 1
  for (int kt = 0; kt < NTILE; ++kt) {
    const bf16_t* sk = lds + (kt & 1) * AT_STAGE; const bf16_t* sv = sk + KST;
    const bool more = (kt + 1) < NTILE;
    if (more) { rk0 = *(const uint4*)(kp0 + (size_t)(kt + 1) * ks0); rv = *(const uint4*)(vp + (kt + 1) * 64); }
    bf16x8 vfr[2][2][2];
#pragma unroll
    for (int kb = 0; kb < 2; ++kb)
#pragma unroll
      for (int s = 0; s < 2; ++s)
#pragma unroll
        for (int db = 0; db < 2; ++db) vfr[kb][s][db] = *(const bf16x8*)(sv + (db * 32 + r) * VROW + kb * 32 + 16 * s + 8 * h);
    __builtin_amdgcn_sched_barrier(0);
#pragma unroll
    for (int c = 0; c < 2; ++c) {
      f32x16 st[2];
      bf16x8 kf[2][2];
#pragma unroll
      for (int kb = 0; kb < 2; ++kb)
#pragma unroll
        for (int s = 0; s < 2; ++s) kf[kb][s] = *(const bf16x8*)(sk + (kb * 32 + r) * KROW + (2 * c + s) * 16 + h * 8);
#pragma unroll
      for (int s = 0; s < 2; ++s)
#pragma unroll
        for (int kb = 0; kb < 2; ++kb) st[kb] = MFMA(kf[kb][s], qf[2 * c + s], (s == 0) ? NM[c] : st[kb]);
      float mx = st[0][0];
#pragma unroll
      for (int i = 1; i < 16; ++i) mx = fmaxf(mx, st[0][i]);
#pragma unroll
      for (int i = 0; i < 16; ++i) mx = fmaxf(mx, st[1][i]);
      mx = xh_max(mx);
      if (kt == 0 || __any(mx > 8.f)) {
        const float d = (kt == 0) ? mx : fmaxf(mx, 0.f);
        const float alpha = ex2(-d);
#pragma unroll
        for (int kb = 0; kb < 2; ++kb)
#pragma unroll
          for (int i = 0; i < 16; ++i) st[kb][i] -= d;
#pragma unroll
        for (int i = 0; i < 16; ++i) NM[c][i] -= d;
        if (kt != 0) {
#pragma unroll
          for (int db = 0; db < 2; ++db)
#pragma unroll
            for (int i = 0; i < 16; ++i) ot[c][db][i] *= alpha;
          lacc[c] *= alpha;
        }
      }
#pragma unroll
      for (int kb = 0; kb < 2; ++kb)
#pragma unroll
        for (int s = 0; s < 2; ++s) {
          typedef __attribute__((ext_vector_type(4))) unsigned u32x4;
          u32x4 pp;
#pragma unroll
          for (int e = 0; e < 4; ++e) {
            const float p0 = ex2(st[kb][8 * s + 2 * e]), p1 = ex2(st[kb][8 * s + 2 * e + 1]);
            lacc[c] += p0 + p1;
            pp[e] = pk2(p0, p1);
          }
          const bf16x8 pf = __builtin_bit_cast(bf16x8, pp);
#pragma unroll
          for (int db = 0; db < 2; ++db) ot[c][db] = MFMA(vfr[kb][s][db], pf, ot[c][db]);
        }
    }
    if (more) {
      bf16_t* nk_ = lds + ((kt + 1) & 1) * AT_STAGE;
      *(uint4*)(nk_ + lk0) = rk0;
      *(uint4*)(nk_ + KST + lv) = rv;
    }
    __syncthreads();
  }
#pragma unroll
  for (int c = 0; c < 2; ++c) lsum[c] = xh_sum(lacc[c]);
}

DI bf16x8 ldq(const bf16_t* p) { return *(const bf16x8*)p; }

DI void attn_item(const WS& w, int type, int b, int head, int qt, bf16_t* lds, float lam, float post, const float* __restrict__ subg) {
  const int tid_ = otid();
  const int lane = tid_ & 63, wave = tid_ >> 6;
  const int r = lane & 31, h = lane >> 5;
  const int t = b * SEQ + qt * 256 + wave * 32 + r;
  f32x16 ot[2]; float l;
  if (type == 2) {
    const int kvh = head >> 2;
    bf16_t* qrow = w.QA + (size_t)t * 512 + head * 64;
    bf16x8 qf[4];
#pragma unroll
    for (int s = 0; s < 4; ++s) qf[s] = ldq(qrow + s * 16 + h * 8);
    flash<64>(qf, w.KA + (size_t)b * SEQ * 128 + kvh * 64, 128, nullptr, 0, w.VAT + (size_t)(b * 2 + kvh) * 64 * SEQ, lds, ot, l);
    const float inv = 1.f / l;
    float o2[2][16];
#pragma unroll
    for (int db = 0; db < 2; ++db)
#pragma unroll
      for (int i = 0; i < 16; ++i) o2[db][i] = ot[db][i] * inv;
    wave_rows_bf16((unsigned char*)lds + wave * EPI_WAVE, o2, w.QA + (size_t)(t - r) * 512 + head * 64, 512, lane);
  } else if (type == 1) {
    bf16_t* qrow = w.QCN + (size_t)t * 512 + head * 64;
    const bf16_t* qr2 = w.QCR + (size_t)t * 256 + head * 32;
    bf16x8 qf[6];
#pragma unroll
    for (int s = 0; s < 4; ++s) qf[s] = ldq(qrow + s * 16 + h * 8);
#pragma unroll
    for (int s = 0; s < 2; ++s) qf[4 + s] = ldq(qr2 + s * 16 + h * 8);
    flash<96>(qf, w.KCN + (size_t)b * SEQ * 512 + head * 64, 512, w.KR + (size_t)b * SEQ * 32, 32, w.VCT + (size_t)(b * 8 + head) * 64 * SEQ, lds, ot, l);
    const float inv = 1.f / l;
    float o2[2][16];
#pragma unroll
    for (int db = 0; db < 2; ++db)
#pragma unroll
      for (int i = 0; i < 16; ++i) o2[db][i] = ot[db][i] * inv;
    wave_rows_bf16((unsigned char*)lds + wave * EPI_WAVE, o2, w.QCN + (size_t)(t - r) * 512 + head * 64, 512, lane);
  } else {
    bf16_t* qrow = w.QB + (size_t)t * 512 + head * 64;
    bf16x8 qfb[4];
#pragma unroll
    for (int s = 0; s < 2; ++s) { qfb[s] = ldq(qrow + s * 16 + h * 8); qfb[2 + s] = ldq(qrow + 32 + s * 16 + h * 8); }
    const bf16_t* kb = w.KB + (size_t)b * SEQ * 512 + head * 64;
    const bf16_t* vt = w.VBT + (size_t)(b * 8 + head) * 64 * SEQ;
    f32x16 ob[2][2]; float lb[2];
    flash_b(qfb, kb, 512, vt, lds, ob, lb);
    const float i0 = 1.f / lb[0], i1 = lam / lb[1];
    float ss = 0.f;
#pragma unroll
    for (int db = 0; db < 2; ++db)
#pragma unroll
      for (int i = 0; i < 16; ++i) { const float o = i0 * ob[0][db][i] - i1 * ob[1][db][i]; ot[db][i] = o; ss += o * o; }
    ss = xh_sum(ss);
    const float rs = rsqrtf(ss * (1.f / 64.f) + EPS) * post;
    float o2[2][16];
#pragma unroll
    for (int db = 0; db < 2; ++db)
#pragma unroll
      for (int i = 0; i < 16; ++i) o2[db][i] = ot[db][i] * rs * subg[db * 32 + crow(i, h)];
    wave_rows_bf16((unsigned char*)lds + wave * EPI_WAVE, o2, w.QB + (size_t)(t - r) * 512 + head * 64, 512, lane);
  }
}

__global__ void __launch_bounds__(512) fwd_kernel(Params p) {
  extern __shared__ __attribute__((aligned(16))) unsigned char lds_raw[];
  cg::grid_group grid = cg::this_grid();
  bf16_t* lds = (bf16_t*)lds_raw;
  float* ldsf = (float*)lds_raw;
  float* rstd = (float*)(lds_raw + LDS_RSTD_OFF);
  float* ssq = (float*)(lds_raw + LDS_SSQ_OFF);
  const WS w = make_ws(p.ws);
  const int tid = threadIdx.x, lane = tid & 63, wave = tid >> 6;
  const int wm = wave & 1, wn = wave >> 1, r = lane & 31, h = lane >> 5;
  const int G = gridDim.x;

  for (int i = blockIdx.x * 512 + tid; i < 2048 * 16; i += G * 512) {
    const int pos = i >> 4, j = i & 15;
    const float inv = powf(10000.f, -(float)(2 * j) / 32.f);
    const float ang = (float)pos * inv;
    w.TABC[i] = make_float2(cosf(ang), sinf(ang));
  }
  for (int i = blockIdx.x * 512 + tid; i < 2048 * 4; i += G * 512) {
    const int pos = i >> 2, j = i & 3;
    const float inv = powf(500000.f, -(float)(2 * j) / 8.f);
    const float ang = (float)pos * inv;
    w.TABB[i] = make_float2(cosf(ang), sinf(ang));
  }
  if (blockIdx.x == 0 && tid < DEPTH) {
    const float* lf = p.b_lambda + tid * 128;
    float s1 = 0.f, s2 = 0.f;
    for (int i = 0; i < 32; ++i) { s1 += lf[i] * lf[32 + i]; s2 += lf[64 + i] * lf[96 + i]; }
    w.LAM[tid] = expf(s1) - expf(s2) + p.lam_init[tid];
  }
  convert_T(p.w_in, INC, 1024, NP1, w.WP1, 1024, nullptr, ldsf);
  convert_T(p.c_w_uq, 768, 384, 768, w.WUQ, 384, p.c_q_norm, ldsf);
  convert_T(p.c_w_ukv, 1024, 256, 1024, w.WUKV, 256, p.c_kv_norm, ldsf);
  grid.sync();

  for (int layer = 0; layer < DEPTH; ++layer) {
    bf16_t* xb = (bf16_t*)p.out + (size_t)NT * DM;
    for (int tile = blockIdx.x; tile < NT / 128; tile += G) {
      const int tok0 = tile * 128;
      bf16_t* Ht = w.H + (size_t)tok0 * DM;
      bf16_t* CQ = w.T2 + (size_t)tok0 * 2048;
      bf16_t* CKV = CQ + 128 * 384;
      __syncthreads();
      if (layer == 0) rmsnorm_tile<false>(p.x + (size_t)tok0 * DM, p.ln1_g, Ht, nullptr);
      else rmsnorm_tile_b(xb + (size_t)tok0 * DM, p.ln1_g + layer * DM, Ht);
      const float* aqg = p.a_q_norm + layer * 64; const float* akg = p.a_k_norm + layer * 64;
      gemm_multi(Ht, DM, w.WP1, 1024, 1024, 12, lds,
                 [&](f32x16 (&acc)[2][2], int nt, unsigned char* sl) {
          const int t__ = otid(); const int lane = t__ & 63, wave = t__ >> 6, wm = wave & 1, wn = wave >> 1, r = lane & 31, h = lane >> 5; (void)wm; (void)wn; (void)r; (void)h; (void)lane; p1_epi(acc, nt, tok0, w, aqg, akg, CQ, CKV, sl, ssq); });
      __syncthreads();
      if (tid < 256) {
        const int t_ = tid & 127;
        float ssum = 0.f;
        if (tid < 128) { for (int q = 0; q < 6; ++q) ssum += ssq[q * 128 + t_]; rstd[tid] = rsqrtf(ssum * (1.f / 384.f) + EPS); }
        else { for (int q = 0; q < 4; ++q) ssum += ssq[(6 + q) * 128 + t_]; rstd[tid] = rsqrtf(ssum * (1.f / 256.f) + EPS); }
      }
      gemm_multi(CQ, 384, w.WUQ, 384, 384, 3, lds, [&](f32x16 (&acc)[2][2], int nt, unsigned char*) {
          const int t__ = otid(); const int lane = t__ & 63, wave = t__ >> 6, wm = wave & 1, wn = wave >> 1, r = lane & 31, h = lane >> 5; (void)wm; (void)wn; (void)r; (void)h; (void)lane;
#pragma unroll
          for (int nb = 0; nb < 2; ++nb) {
            const int g32 = nt * 8 + wn * 2 + nb, hd = g32 / 3, part = g32 % 3;
#pragma unroll
            for (int mb = 0; mb < 2; ++mb) {
              const int tl = wm * 64 + mb * 32 + r, t = tok0 + tl, s = t & (SEQ - 1);
              const float rs = rstd[tl] * (0.10206207261596577f * LOG2E);
              if (part < 2) store16v(w.QCN + (size_t)t * 512 + hd * 64 + part * 32, acc[nb][mb], rs, h);
              else { float o[16]; rot32(acc[nb][mb], nullptr, rs, w.TABC + s * 16, h, o); store16(w.QCR + (size_t)t * 256 + hd * 32, o, h); }
            }
          }
        });
      gemm_multi(CKV, 256, w.WUKV, 256, 256, 4, lds, [&](f32x16 (&acc)[2][2], int nt, unsigned char*) {
          const int t__ = otid(); const int lane = t__ & 63, wave = t__ >> 6, wm = wave & 1, wn = wave >> 1, r = lane & 31, h = lane >> 5; (void)wm; (void)wn; (void)r; (void)h; (void)lane;
#pragma unroll
          for (int nb = 0; nb < 2; ++nb) {
            const int g32 = nt * 8 + wn * 2 + nb, hd = g32 >> 2, part = g32 & 3;
#pragma unroll
            for (int mb = 0; mb < 2; ++mb) {
              const int tl = wm * 64 + mb * 32 + r, t = tok0 + tl, s = t & (SEQ - 1), b = t >> 11;
              const float rs = rstd[128 + tl];
              if (part < 2) store16v(w.KCN + (size_t)t * 512 + hd * 64 + part * 32, acc[nb][mb], rs, h);
              else store16T(w.VCT + ((size_t)(b * 8 + hd) * 64 + (part - 2) * 32) * SEQ + vperm(s), acc[nb][mb], rs, h);
            }
          }
        });
    }
    grid.sync();

    {
      const float* win = p.w_in + (size_t)layer * 1024 * INC;
      convert_T(win + NP1, INC, 1024, 3072, w.WG, 1024, nullptr, ldsf);
      for (int n = 0; n < 3; ++n)
        convert_T(p.w_branch + (size_t)(layer * 3 + n) * 512 * 1024, 1024, 512, 1024, w.WB + (size_t)n * 1024 * 512, 512, nullptr, ldsf);
      convert_T(p.w_out + (size_t)layer * 1024 * 1024, 1024, 1024, 1024, w.WO, 1024, nullptr, ldsf);
      convert_T(p.w_ff1 + (size_t)layer * 1024 * 4096, 4096, 1024, 4096, w.W1, 1024, nullptr, ldsf);
      convert_T(p.w_ff2 + (size_t)layer * 4096 * 1024, 1024, 4096, 1024, w.W2, 4096, nullptr, ldsf);
      if (layer + 1 < DEPTH) {
        const int l1 = layer + 1;
        convert_T(p.w_in + (size_t)l1 * 1024 * INC, INC, 1024, NP1, w.WP1, 1024, nullptr, ldsf);
        convert_T(p.c_w_uq + (size_t)l1 * 384 * 768, 768, 384, 768, w.WUQ, 384, p.c_q_norm + l1 * 384, ldsf);
        convert_T(p.c_w_ukv + (size_t)l1 * 256 * 1024, 1024, 256, 1024, w.WUKV, 256, p.c_kv_norm + l1 * 256, ldsf);
      }
      const float lam = w.LAM[layer];
      const float post = 1.f - p.lam_init[layer];
      const float* subg = p.b_subln + layer * 64;
      for (int v = blockIdx.x; v < 3072; v += G) {
        const int type = v >> 10, wi = v & 1023;
        const int k = wi >> 8, blk = wi & 255, xc = blk & 7, j = blk >> 3;
        int b, head; const int qt = j & 7;
        if (type == 2) { const int pair = k * 8 + xc; b = pair >> 1; head = (pair & 1) * 4 + (j >> 3); }
        else { const int pair = (k * 8 + xc) * 4 + (j >> 3); b = pair >> 3; head = pair & 7; }
        attn_item(w, type, b, head, qt, lds, lam, post, subg);
      }
    }
    grid.sync();

    for (int tile = blockIdx.x; tile < NT / 128; tile += G) {
      const int tok0 = tile * 128;
      bf16_t* Ht = w.H + (size_t)tok0 * DM;
      bf16_t* MG = w.T2 + (size_t)tok0 * 2048;
      uint4* GT = (uint4*)(w.QCR + (size_t)tok0 * 256);
      bf16_t* xt = xb + (size_t)tok0 * DM;
      const float* xin = p.x + (size_t)tok0 * DM;
      const unsigned char* segw = p.ws + (size_t)tok0 * 1024;
      for (int jt = 0; jt < 4; ++jt) {
        f32x16 mg[2][2];
#pragma unroll
        for (int nb = 0; nb < 2; ++nb)
#pragma unroll
          for (int mb = 0; mb < 2; ++mb)
#pragma unroll
            for (int i = 0; i < 16; ++i) mg[nb][mb][i] = 0.f;
        gemm_merge(Ht, p.ws + (size_t)tok0 * 1024, w.WG + (size_t)jt * 256 * 1024, w.WB + (size_t)jt * 256 * 512, lds, [&](f32x16 (&acc)[2][2], int sg) {
          const int t__ = otid(); const int lane = t__ & 63, wave = t__ >> 6;
          if ((sg & 1) == 0) {
#pragma unroll
            for (int nb = 0; nb < 2; ++nb)
#pragma unroll
              for (int mb = 0; mb < 2; ++mb) {
                unsigned gq[8];
#pragma unroll
                for (int i = 0; i < 8; ++i) {
                  const float g0 = __builtin_amdgcn_rcpf(1.f + ex2(-LOG2E * acc[nb][mb][2 * i]));
                  const float g1 = __builtin_amdgcn_rcpf(1.f + ex2(-LOG2E * acc[nb][mb][2 * i + 1]));
                  gq[i] = pk2(g0, g1);
                }
                uint4* gd = GT + ((wave * 4 + nb * 2 + mb) * 2) * 64 + lane;
                gd[0] = make_uint4(gq[0], gq[1], gq[2], gq[3]); gd[64] = make_uint4(gq[4], gq[5], gq[6], gq[7]);
              }
          } else {
#pragma unroll
            for (int nb = 0; nb < 2; ++nb)
#pragma unroll
              for (int mb = 0; mb < 2; ++mb) {
                const uint4* gd = GT + ((wave * 4 + nb * 2 + mb) * 2) * 64 + lane;
                const uint4 ga_ = gd[0], gb_ = gd[64];
                const unsigned gq[8] = {ga_.x, ga_.y, ga_.z, ga_.w, gb_.x, gb_.y, gb_.z, gb_.w};
#pragma unroll
                for (int i = 0; i < 8; ++i) {
                  mg[nb][mb][2 * i] += bflo(gq[i]) * acc[nb][mb][2 * i];
                  mg[nb][mb][2 * i + 1] += bfhi(gq[i]) * acc[nb][mb][2 * i + 1];
                }
              }
          }
        });
        {
          const int t__ = otid(); const int lane = t__ & 63, wave = t__ >> 6, wm = wave & 1, wn = wave >> 1;
          __syncthreads();
#pragma unroll
          for (int mb = 0; mb < 2; ++mb) {
            float o2[2][16];
#pragma unroll
            for (int nb = 0; nb < 2; ++nb)
#pragma unroll
              for (int i = 0; i < 16; ++i) o2[nb][i] = mg[nb][mb][i];
            wave_rows_bf16(lds_raw + wave * EPI_WAVE, o2, MG + (size_t)(wm * 64 + mb * 32) * DM + jt * 256 + wn * 64, DM, lane);
          }
        }
      }
      gemm_multi(MG, DM, w.WO, 1024, 1024, 4, lds, [&](f32x16 (&acc)[2][2], int jt, unsigned char* sl) {
          const int t__ = otid(); const int lane = t__ & 63, wave = t__ >> 6, wm = wave & 1, wn = wave >> 1, r = lane & 31, h = lane >> 5; (void)wm; (void)wn; (void)r; (void)h; (void)lane;
#pragma unroll
          for (int nb = 0; nb < 2; ++nb)
#pragma unroll
            for (int mb = 0; mb < 2; ++mb) {
              const size_t ro = (size_t)(wm * 64 + mb * 32) * DM + jt * 256 + wn * 64 + nb * 32;
              if (layer == 0) wave_rows_res<1, 0>(sl, acc[nb][mb], xin + ro, xt + ro, 0, lane);
              else wave_rows_res<0, 0>(sl, acc[nb][mb], xt + ro, xt + ro, 0, lane);
            }
        });
      __syncthreads();
      rmsnorm_tile_b(xt, p.ln2_g + layer * DM, Ht);
      for (int c = 0; c < 2; ++c) {
        gemm_multi(Ht, DM, w.W1 + (size_t)(c * 2048) * 1024, 1024, 1024, 8, lds, [&](f32x16 (&acc)[2][2], int jt, unsigned char* sl) {
            const int t__ = otid(); const int lane = t__ & 63, wave = t__ >> 6, wm = wave & 1, wn = wave >> 1;
#pragma unroll
            for (int mb = 0; mb < 2; ++mb) {
              float o2[2][16];
#pragma unroll
              for (int nb = 0; nb < 2; ++nb)
#pragma unroll
                for (int i = 0; i < 16; ++i) { const float v = fmaxf(acc[nb][mb][i], 0.f); o2[nb][i] = v * v; }
              wave_rows_bf16(sl, o2, MG + (size_t)(wm * 64 + mb * 32) * 2048 + jt * 256 + wn * 64, 2048, lane);
            }
          });
        gemm_multi(MG, 2048, w.W2 + c * 2048, 4096, 2048, 4, lds, [&](f32x16 (&acc)[2][2], int jt, unsigned char* sl) {
            const int t__ = otid(); const int lane = t__ & 63, wave = t__ >> 6, wm = wave & 1, wn = wave >> 1;
#pragma unroll
            for (int nb = 0; nb < 2; ++nb)
#pragma unroll
              for (int mb = 0; mb < 2; ++mb) {
                const size_t ro = (size_t)(wm * 64 + mb * 32) * DM + jt * 256 + wn * 64 + nb * 32;
                if (layer == DEPTH - 1 && c == 1) {
                  const size_t so = (jt == 0) ? OFF_QA : (jt == 1) ? OFF_QB : (jt == 2) ? OFF_KB : OFF_QCN;
                  float* d = (float*)(segw + so) + (size_t)(wm * 64 + mb * 32) * 256 + wn * 64 + nb * 32;
                  wave_rows_res<0, 1>(sl, acc[nb][mb], xt + ro, d, 256, lane);
                } else wave_rows_res<0, 0>(sl, acc[nb][mb], xt + ro, xt + ro, 0, lane);
              }
          });
      }
    }
  }
  grid.sync();
  for (int tile = blockIdx.x; tile < NT / 128; tile += G) {
    const int tok0 = tile * 128;
    final_norm(p.ws + (size_t)tok0 * 1024, p.final_g, p.out + (size_t)tok0 * DM);
  }
}

extern "C" void kernel_launch(void* const* d_in, const int* in_sizes, int n_in, void* d_out, int out_size, void* d_ws, size_t ws_size,
                              hipStream_t stream) {
  static int grid_blocks = 0;
  if (!grid_blocks) {
    int dev = 0, cus = 0, per_cu = 0;
    hipGetDevice(&dev);
    hipDeviceGetAttribute(&cus, hipDeviceAttributeMultiprocessorCount, dev);
    hipFuncSetAttribute((const void*)fwd_kernel, hipFuncAttributeMaxDynamicSharedMemorySize, LDS_BYTES);
    hipOccupancyMaxActiveBlocksPerMultiprocessor(&per_cu, (const void*)fwd_kernel, 512, LDS_BYTES);
    if (per_cu < 1) per_cu = 1;
    grid_blocks = cus * per_cu;
    if (grid_blocks > 256) grid_blocks = 256;
    if (ws_size < WS_END) fprintf(stderr, "workspace too small: %zu < %zu\n", ws_size, (size_t)WS_END);
  }
  Params p{};
  p.x = (const float*)d_in[0]; p.ln1_g = (const float*)d_in[1]; p.w_in = (const float*)d_in[2];
  p.a_q_norm = (const float*)d_in[3]; p.a_k_norm = (const float*)d_in[4]; p.b_lambda = (const float*)d_in[5];
  p.b_subln = (const float*)d_in[6]; p.c_q_norm = (const float*)d_in[7]; p.c_kv_norm = (const float*)d_in[8];
  p.c_w_uq = (const float*)d_in[9]; p.c_w_ukv = (const float*)d_in[10]; p.w_branch = (const float*)d_in[11];
  p.w_out = (const float*)d_in[12]; p.ln2_g = (const float*)d_in[13]; p.w_ff1 = (const float*)d_in[14];
  p.w_ff2 = (const float*)d_in[15]; p.final_g = (const float*)d_in[16];
  p.out = (float*)d_out; p.ws = (unsigned char*)d_ws;
  p.lam_init[0] = 0.2f;
  p.lam_init[1] = 0.35550906759f;
  p.lam_init[2] = 0.47071301834f;
  p.lam_init[3] = 0.55605820416f;
  void* args[] = {&p};
  hipError_t e = hipLaunchCooperativeKernel((const void*)fwd_kernel, dim3(grid_blocks), dim3(512), args, LDS_BYTES, stream);
  if (e != hipSuccess) fprintf(stderr, "cooperative launch failed: %s (grid %d)\n", hipGetErrorString(e), grid_blocks);
}
```

```cpp
#include <hip/hip_runtime.h>
#include <hip/hip_cooperative_groups.h>
#include <cstdio>
namespace cg = cooperative_groups;

#define DI __device__ __forceinline__
typedef unsigned short bf16_t;
typedef __attribute__((ext_vector_type(8))) short bf16x8;
typedef __attribute__((ext_vector_type(4))) short s16x4;
typedef __attribute__((ext_vector_type(16))) float f32x16;
#define MFMA(a, b, c) __builtin_amdgcn_mfma_f32_32x32x16_bf16((a), (b), (c), 0, 0, 0)

constexpr int NT = 32768;
constexpr int SEQ = 2048;
constexpr int DM = 1024;
constexpr int INC = 6048;
constexpr int NP1 = 2976;
constexpr int DEPTH = 4;
constexpr float LOG2E = 1.4426950408889634f;
constexpr float EPS = 1e-6f;

constexpr size_t SZ_T = (size_t)NT * 2;
constexpr size_t OFF_QA = 0;
constexpr size_t OFF_KA = OFF_QA + SZ_T * 512;
constexpr size_t OFF_VAT = OFF_KA + SZ_T * 128;
constexpr size_t OFF_QB = OFF_VAT + SZ_T * 128;
constexpr size_t OFF_KB = OFF_QB + SZ_T * 512;
constexpr size_t OFF_VBT = OFF_KB + SZ_T * 512;
constexpr size_t OFF_QCN = OFF_VBT + SZ_T * 512;
constexpr size_t OFF_QCR = OFF_QCN + SZ_T * 512;
constexpr size_t OFF_KCN = OFF_QCR + SZ_T * 256;
constexpr size_t OFF_KR = OFF_KCN + SZ_T * 512;
constexpr size_t OFF_VCT = OFF_KR + SZ_T * 32;
constexpr size_t OFF_H = OFF_VCT + SZ_T * 512;
constexpr size_t OFF_T2 = OFF_H + SZ_T * 1024;
constexpr size_t OFF_WP1 = OFF_T2 + SZ_T * 2048;
constexpr size_t OFF_WUQ = OFF_WP1 + (size_t)3072 * 1024 * 2;
constexpr size_t OFF_WUKV = OFF_WUQ + (size_t)768 * 384 * 2;
constexpr size_t OFF_WG = OFF_WUKV + (size_t)1024 * 256 * 2;
constexpr size_t OFF_WB = OFF_WG + (size_t)3072 * 1024 * 2;
constexpr size_t OFF_WO = OFF_WB + (size_t)3 * 1024 * 512 * 2;
constexpr size_t OFF_W1 = OFF_WO + (size_t)1024 * 1024 * 2;
constexpr size_t OFF_W2 = OFF_W1 + (size_t)4096 * 1024 * 2;
constexpr size_t OFF_TABC = OFF_W2 + (size_t)4096 * 1024 * 2;
constexpr size_t OFF_TABB = OFF_TABC + (size_t)2048 * 16 * 8;
constexpr size_t OFF_LAM = OFF_TABB + (size_t)2048 * 4 * 8;
constexpr size_t WS_END = OFF_LAM + 64;

constexpr int STG_A = 128 * 128;
constexpr int STG_B = 256 * 128;
constexpr int STG = STG_A + STG_B;
constexpr int NSTG = 3;
constexpr int LDS_GEMM_BYTES = NSTG * STG;
constexpr int LDS_RSTD_OFF = LDS_GEMM_BYTES;
constexpr int LDS_SSQ_OFF = LDS_GEMM_BYTES + 1024;
constexpr int LDS_BYTES = LDS_GEMM_BYTES + 1024 + 5120;
constexpr int KST = 64 * 104;
constexpr int VROW = 72;
constexpr int VST = 64 * VROW;
constexpr int AT_STAGE = KST + VST;
#define WAIT_VM(n) asm volatile("s_waitcnt vmcnt(" #n ")" ::: "memory")
#define RAW_BARRIER() asm volatile("s_waitcnt lgkmcnt(0)\n\ts_barrier" ::: "memory")

struct Params {
  const float* x; const float* ln1_g; const float* w_in; const float* a_q_norm; const float* a_k_norm;
  const float* b_lambda; const float* b_subln; const float* c_q_norm; const float* c_kv_norm;
  const float* c_w_uq; const float* c_w_ukv; const float* w_branch; const float* w_out; const float* ln2_g;
  const float* w_ff1; const float* w_ff2; const float* final_g;
  float* out; unsigned char* ws;
  float lam_init[4];
};

DI unsigned pk2(float a, float b) {
  typedef __attribute__((ext_vector_type(2))) __bf16 bf2;
  bf2 v = {(__bf16)a, (__bf16)b};
  return __builtin_bit_cast(unsigned, v);
}
DI bf16_t f2bf(float a) { return (bf16_t)(pk2(a, 0.f) & 0xffffu); }
DI float bf2f(unsigned v) { return __uint_as_float(v << 16); }
DI float bflo(unsigned v) { return __uint_as_float(v << 16); }
DI float bfhi(unsigned v) { return __uint_as_float(v & 0xffff0000u); }
DI float xh_max(float v) { auto r = __builtin_amdgcn_permlane32_swap(__float_as_uint(v), __float_as_uint(v), false, false); return fmaxf(__uint_as_float(r[0]), __uint_as_float(r[1])); }
DI float xh_sum(float v) { auto r = __builtin_amdgcn_permlane32_swap(__float_as_uint(v), __float_as_uint(v), false, false); return __uint_as_float(r[0]) + __uint_as_float(r[1]); }
DI float xh_other(float v, int h) { auto r = __builtin_amdgcn_permlane32_swap(__float_as_uint(v), __float_as_uint(v), false, false); return __uint_as_float(h ? r[0] : r[1]); }
DI float ex2(float v) { return __builtin_amdgcn_exp2f(v); }
DI int crow(int i, int h) { return (i & 3) + 8 * (i >> 2) + 4 * h; }
DI int otid() { int t = threadIdx.x; asm volatile("" : "+v"(t)); return t; }

DI void store16(bf16_t* dst, const float* o, int h) {
#pragma unroll
  for (int g = 0; g < 4; ++g) {
    uint2 v; v.x = pk2(o[4 * g], o[4 * g + 1]); v.y = pk2(o[4 * g + 2], o[4 * g + 3]);
    *(uint2*)(dst + 8 * g + 4 * h) = v;
  }
}
DI void store16v(bf16_t* dst, const f32x16& o, float sc, int h) {
#pragma unroll
  for (int g = 0; g < 4; ++g) {
    uint2 v; v.x = pk2(o[4 * g] * sc, o[4 * g + 1] * sc); v.y = pk2(o[4 * g + 2] * sc, o[4 * g + 3] * sc);
    *(uint2*)(dst + 8 * g + 4 * h) = v;
  }
}
DI void store16T(bf16_t* dst, const f32x16& o, float sc, int h) {
#pragma unroll
  for (int i = 0; i < 16; ++i) dst[(size_t)crow(i, h) * SEQ] = f2bf(o[i] * sc);
}
DI int vperm(int s) { return (s & ~12) | ((s & 4) << 1) | ((s & 8) >> 1); }

constexpr int EPI_ROWB = 144;
constexpr int EPI_WAVE = 32 * EPI_ROWB;
DI void wave_rows_bf16(unsigned char* lw, const float (&o)[2][16], bf16_t* dst0, int row_stride, int lane) {
  const int r = lane & 31, h = lane >> 5;
#pragma unroll
  for (int nb = 0; nb < 2; ++nb)
#pragma unroll
    for (int g = 0; g < 4; ++g) {
      uint2 v; v.x = pk2(o[nb][4 * g], o[nb][4 * g + 1]); v.y = pk2(o[nb][4 * g + 2], o[nb][4 * g + 3]);
      *(uint2*)(lw + r * EPI_ROWB + (nb * 32 + 8 * g + 4 * h) * 2) = v;
    }
#pragma unroll
  for (int it = 0; it < 4; ++it) {
    const int id = it * 64 + lane, row = id >> 3, c = id & 7;
    const uint4 v = *(const uint4*)(lw + row * EPI_ROWB + c * 16);
    *(uint4*)(dst0 + (size_t)row * row_stride + c * 8) = v;
  }
  asm volatile("" ::: "memory");
}
DI void wave_rows_rmw_f32(unsigned char* lw, const f32x16& a, const float* src0, float* dst0, int lane) {
  const int r = lane & 31, h = lane >> 5;
  float4 xv[4];
#pragma unroll
  for (int it = 0; it < 4; ++it) { const int id = it * 64 + lane; xv[it] = *(const float4*)(src0 + (size_t)(id >> 3) * DM + (id & 7) * 4); }
#pragma unroll
  for (int g = 0; g < 4; ++g) {
    float4 v = {a[4 * g], a[4 * g + 1], a[4 * g + 2], a[4 * g + 3]};
    *(float4*)(lw + r * EPI_ROWB + (8 * g + 4 * h) * 4) = v;
  }
#pragma unroll
  for (int it = 0; it < 4; ++it) {
    const int id = it * 64 + lane, row = id >> 3, c = id & 7;
    const float4 v = *(const float4*)(lw + row * EPI_ROWB + c * 16);
    float4 x = xv[it]; x.x += v.x; x.y += v.y; x.z += v.z; x.w += v.w;
    *(float4*)(dst0 + (size_t)row * DM + c * 4) = x;
  }
  asm volatile("" ::: "memory");
}

typedef _Float16 hf2 __attribute__((ext_vector_type(2)));
DI unsigned pkh2(float a, float b) { hf2 v = {(_Float16)a, (_Float16)b}; return __builtin_bit_cast(unsigned, v); }
DI float hlo(unsigned u) { return (float)__builtin_bit_cast(hf2, u)[0]; }
DI float hhi(unsigned u) { return (float)__builtin_bit_cast(hf2, u)[1]; }
template <int SRCF, int DSTF>
DI void wave_rows_res(unsigned char* lw, const f32x16& a, const void* src0, void* dst0, int dstride, int lane) {
  const int r = lane & 31, h = lane >> 5;
  float4 xv[4];
#pragma unroll
  for (int it = 0; it < 4; ++it) {
    const int id = it * 64 + lane; const size_t off = (size_t)(id >> 3) * DM + (id & 7) * 4;
    if (SRCF) xv[it] = *(const float4*)((const float*)src0 + off);
    else { const uint2 u = *(const uint2*)((const bf16_t*)src0 + off); xv[it] = make_float4(hlo(u.x), hhi(u.x), hlo(u.y), hhi(u.y)); }
  }
#pragma unroll
  for (int g = 0; g < 4; ++g) {
    float4 v = {a[4 * g], a[4 * g + 1], a[4 * g + 2], a[4 * g + 3]};
    *(float4*)(lw + r * EPI_ROWB + (8 * g + 4 * h) * 4) = v;
  }
#pragma unroll
  for (int it = 0; it < 4; ++it) {
    const int id = it * 64 + lane, row = id >> 3, c = id & 7;
    const float4 v = *(const float4*)(lw + row * EPI_ROWB + c * 16);
    float4 x = xv[it]; x.x += v.x; x.y += v.y; x.z += v.z; x.w += v.w;
    if (DSTF) *(float4*)((float*)dst0 + (size_t)row * dstride + c * 4) = x;
    else { uint2 o; o.x = pkh2(x.x, x.y); o.y = pkh2(x.z, x.w); *(uint2*)((bf16_t*)dst0 + (size_t)row * DM + c * 4) = o; }
  }
  asm volatile("" ::: "memory");
}
DI void rmsnorm_tile_b(const bf16_t* x, const float* __restrict__ g, bf16_t* __restrict__ dst) {
  const int tid_ = otid();
  const int lane = tid_ & 63, wave = tid_ >> 6;
  float4 gg[4];
#pragma unroll
  for (int j = 0; j < 4; ++j) gg[j] = *(const float4*)(g + j * 256 + lane * 4);
#pragma unroll 1
  for (int r0 = wave * 16; r0 < wave * 16 + 16; r0 += 8) {
    uint2 u[8][4];
#pragma unroll
    for (int q = 0; q < 8; ++q)
#pragma unroll
      for (int j = 0; j < 4; ++j) u[q][j] = *(const uint2*)(x + (size_t)(r0 + q) * DM + j * 256 + lane * 4);
#pragma unroll
    for (int q = 0; q < 8; ++q) {
      float4 v[4];
      float ss = 0.f;
#pragma unroll
      for (int j = 0; j < 4; ++j) { v[j] = make_float4(hlo(u[q][j].x), hhi(u[q][j].x), hlo(u[q][j].y), hhi(u[q][j].y)); ss += v[j].x * v[j].x + v[j].y * v[j].y + v[j].z * v[j].z + v[j].w * v[j].w; }
#pragma unroll
      for (int o = 32; o >= 1; o >>= 1) ss += __shfl_xor(ss, o);
      const float rs = rsqrtf(ss * (1.f / 1024.f) + EPS);
#pragma unroll
      for (int j = 0; j < 4; ++j) {
        uint2 o2; o2.x = pk2(v[j].x * rs * gg[j].x, v[j].y * rs * gg[j].y); o2.y = pk2(v[j].z * rs * gg[j].z, v[j].w * rs * gg[j].w);
        *(uint2*)(dst + (size_t)(r0 + q) * DM + j * 256 + lane * 4) = o2;
      }
    }
  }
}
DI void final_norm(const unsigned char* segws, const float* __restrict__ g, float* __restrict__ out) {
  const int tid_ = otid();
  const int lane = tid_ & 63, wave = tid_ >> 6;
  const float* sg[4] = {(const float*)(segws + OFF_QA), (const float*)(segws + OFF_QB), (const float*)(segws + OFF_KB), (const float*)(segws + OFF_QCN)};
  float4 gg[4];
#pragma unroll
  for (int j = 0; j < 4; ++j) gg[j] = *(const float4*)(g + j * 256 + lane * 4);
#pragma unroll 1
  for (int r0 = wave * 16; r0 < wave * 16 + 16; r0 += 4) {
    float4 v[4][4];
#pragma unroll
    for (int q = 0; q < 4; ++q)
#pragma unroll
      for (int j = 0; j < 4; ++j) v[q][j] = *(const float4*)(sg[j] + (size_t)(r0 + q) * 256 + lane * 4);
#pragma unroll
    for (int q = 0; q < 4; ++q) {
      float ss = 0.f;
#pragma unroll
      for (int j = 0; j < 4; ++j) ss += v[q][j].x * v[q][j].x + v[q][j].y * v[q][j].y + v[q][j].z * v[q][j].z + v[q][j].w * v[q][j].w;
#pragma unroll
      for (int o = 32; o >= 1; o >>= 1) ss += __shfl_xor(ss, o);
      const float rs = rsqrtf(ss * (1.f / 1024.f) + EPS);
#pragma unroll
      for (int j = 0; j < 4; ++j) {
        float4 o4 = {v[q][j].x * rs * gg[j].x, v[q][j].y * rs * gg[j].y, v[q][j].z * rs * gg[j].z, v[q][j].w * rs * gg[j].w};
        *(float4*)(out + (size_t)(r0 + q) * DM + j * 256 + lane * 4) = o4;
      }
    }
  }
}

DI void convert_T(const float* __restrict__ src, int ld_src, int K, int N, bf16_t* __restrict__ dst, int ld_dst,
                  const float* __restrict__ g, float* ldsf) {
  const int tid = otid();
  const int ntn = (N + 63) >> 6, ntk = K >> 6;
  const int nt = ntn * ntk;
  const int n4 = (tid & 15) * 4, kb = tid >> 4;
  float4 v[2];
  auto load_tile = [&](int t, float4 (&o)[2]) {
    const int k0 = (t / ntn) * 64, n0 = (t % ntn) * 64;
    const bool ok = (n0 + n4) < N;
#pragma unroll
    for (int i = 0; i < 2; ++i) {
      const int k = kb + 32 * i;
      float4 x = make_float4(0.f, 0.f, 0.f, 0.f);
      if (ok) {
        typedef float f32x4n __attribute__((ext_vector_type(4)));
        const f32x4n q = __builtin_nontemporal_load((const f32x4n*)(src + (size_t)(k0 + k) * ld_src + n0 + n4));
        x = make_float4(q[0], q[1], q[2], q[3]);
      }
      if (g) { const float gg = g[k0 + k]; x.x *= gg; x.y *= gg; x.z *= gg; x.w *= gg; }
      o[i] = x;
    }
  };
  int t = blockIdx.x;
  const int G_ = gridDim.x;
  float4 w1[2] = {make_float4(0.f, 0.f, 0.f, 0.f), make_float4(0.f, 0.f, 0.f, 0.f)};
  if (t < nt) load_tile(t, v);
  if (t + G_ < nt) load_tile(t + G_, w1);
  for (; t < nt; t += G_) {
    const int k0 = (t / ntn) * 64, n0 = (t % ntn) * 64;
    float4 nv[2] = {make_float4(0.f, 0.f, 0.f, 0.f), make_float4(0.f, 0.f, 0.f, 0.f)};
    const int tn = t + 2 * G_;
    if (tn < nt) load_tile(tn, nv);
    __syncthreads();
#pragma unroll
    for (int i = 0; i < 2; ++i) {
      const int k = kb + 32 * i;
      ldsf[(n4 + 0) * 65 + k] = v[i].x; ldsf[(n4 + 1) * 65 + k] = v[i].y; ldsf[(n4 + 2) * 65 + k] = v[i].z; ldsf[(n4 + 3) * 65 + k] = v[i].w;
    }
    __syncthreads();
    {
      const int n2 = tid >> 3, c = (tid & 7) * 8;
      if (n0 + n2 < N) {
        const float* sp = ldsf + n2 * 65 + c;
        uint4 o; o.x = pk2(sp[0], sp[1]); o.y = pk2(sp[2], sp[3]); o.z = pk2(sp[4], sp[5]); o.w = pk2(sp[6], sp[7]);
        *(uint4*)(dst + (size_t)(n0 + n2) * ld_dst + k0 + c) = o;
      }
    }
    v[0] = w1[0]; v[1] = w1[1]; w1[0] = nv[0]; w1[1] = nv[1];
  }
}

template <bool F32OUT>
DI void rmsnorm_tile(const float* x, const float* __restrict__ g, bf16_t* __restrict__ dst, float* dstf) {
  const int tid_ = otid();
  const int lane = tid_ & 63, wave = tid_ >> 6;
  float4 gg[4];
#pragma unroll
  for (int j = 0; j < 4; ++j) gg[j] = *(const float4*)(g + j * 256 + lane * 4);
#pragma unroll 1
  for (int r0 = wave * 16; r0 < wave * 16 + 16; r0 += 4) {
    float4 v[4][4];
#pragma unroll
    for (int q = 0; q < 4; ++q)
#pragma unroll
      for (int j = 0; j < 4; ++j) v[q][j] = *(const float4*)(x + (size_t)(r0 + q) * DM + j * 256 + lane * 4);
#pragma unroll
    for (int q = 0; q < 4; ++q) {
      float ss = 0.f;
#pragma unroll
      for (int j = 0; j < 4; ++j) ss += v[q][j].x * v[q][j].x + v[q][j].y * v[q][j].y + v[q][j].z * v[q][j].z + v[q][j].w * v[q][j].w;
#pragma unroll
      for (int o = 32; o >= 1; o >>= 1) ss += __shfl_xor(ss, o);
      const float rs = rsqrtf(ss * (1.f / 1024.f) + EPS);
#pragma unroll
      for (int j = 0; j < 4; ++j) {
        const float a = v[q][j].x * rs * gg[j].x, b = v[q][j].y * rs * gg[j].y, c = v[q][j].z * rs * gg[j].z, d = v[q][j].w * rs * gg[j].w;
        if (F32OUT) {
          float4 o4 = {a, b, c, d};
          *(float4*)(dstf + (size_t)(r0 + q) * DM + j * 256 + lane * 4) = o4;
        } else {
          uint2 o2; o2.x = pk2(a, b); o2.y = pk2(c, d);
          *(uint2*)(dst + (size_t)(r0 + q) * DM + j * 256 + lane * 4) = o2;
        }
      }
    }
  }
}

template <class Epi>
DI void gemm_tile(const bf16_t* __restrict__ A, int lda, const bf16_t* __restrict__ Bt, int ldb, int K, bf16_t* lds_, Epi epi) {
  unsigned char* lds = (unsigned char*)lds_;
  const int tid = otid(), lane = tid & 63, wave = tid >> 6;
  const int wm = wave & 1, wn = wave >> 1, r = lane & 31, h = lane >> 5;
  const int lr = lane >> 3, lcp = lane & 7;
  const bf16_t* pa[2]; const bf16_t* pb[4];
#pragma unroll
  for (int i = 0; i < 2; ++i) { const int row = (wave * 2 + i) * 8 + lr; pa[i] = A + (size_t)row * lda + ((lcp ^ ((row >> 1) & 7)) * 8); }
#pragma unroll
  for (int i = 0; i < 4; ++i) { const int row = (wave * 4 + i) * 8 + lr; pb[i] = Bt + (size_t)row * ldb + ((lcp ^ ((row >> 1) & 7)) * 8); }
  f32x16 acc[2][2];
#pragma unroll
  for (int nb = 0; nb < 2; ++nb)
#pragma unroll
    for (int mb = 0; mb < 2; ++mb)
#pragma unroll
      for (int i = 0; i < 16; ++i) acc[nb][mb][i] = 0.f;
  const int x = h ^ ((r >> 1) & 7);
  int co[4];
#pragma unroll
  for (int st = 0; st < 4; ++st) co[st] = (x ^ (2 * st)) << 4;
  const int arow = (wm * 64 + r) * 128;
  const int brow = STG_A + (wn * 64 + r) * 128;
  auto issue_part = [&](int kt, int sidx, int part) {
    unsigned char* sa = lds + sidx * STG; unsigned char* sb = sa + STG_A;
    if (part == 0) {
#pragma unroll
      for (int i = 0; i < 2; ++i)
        __builtin_amdgcn_global_load_lds((const unsigned*)(pa[i] + kt * 64), (unsigned*)(sa + (wave * 2 + i) * 1024), 16, 0, 0);
    } else {
#pragma unroll
      for (int i = 2 * (part - 1); i < 2 * part; ++i)
        __builtin_amdgcn_global_load_lds((const unsigned*)(pb[i] + kt * 64), (unsigned*)(sb + (wave * 4 + i) * 1024), 16, 0, 0);
    }
  };
  auto issue = [&](int kt, int sidx) { issue_part(kt, sidx, 0); issue_part(kt, sidx, 1); issue_part(kt, sidx, 2); };
  const int nk = K >> 6;
  WAIT_VM(0);
  RAW_BARRIER();
  issue(0, 0); issue(1, 1);
  int sc = 0, sn = 2;
#pragma unroll 1
  for (int j = 0; j < nk; ++j) {
    if (j + 1 < nk) WAIT_VM(6); else WAIT_VM(0);
    RAW_BARRIER();
    const bool pre = (j + 2) < nk;
    const unsigned char* base = lds + sc * STG;
#pragma unroll
    for (int st = 0; st < 4; ++st) {
      const bf16x8 af0 = *(const bf16x8*)(base + arow + co[st]);
      const bf16x8 af1 = *(const bf16x8*)(base + arow + 4096 + co[st]);
      const bf16x8 bf0 = *(const bf16x8*)(base + brow + co[st]);
      const bf16x8 bf1 = *(const bf16x8*)(base + brow + 4096 + co[st]);
      acc[0][0] = MFMA(bf0, af0, acc[0][0]);
      acc[0][1] = MFMA(bf0, af1, acc[0][1]);
      acc[1][0] = MFMA(bf1, af0, acc[1][0]);
      acc[1][1] = MFMA(bf1, af1, acc[1][1]);
      if (st < 3 && pre) issue_part(j + 2, sn, st);
    }
    sc = (sc == 2) ? 0 : sc + 1; sn = (sn == 2) ? 0 : sn + 1;
  }
  epi(acc);
}

template <class Epi>
DI void gemm_multi(const bf16_t* __restrict__ A, int lda, const bf16_t* __restrict__ Bt, int ldb, int K, int ntiles, bf16_t* lds_, Epi epi) {
  unsigned char* lds = (unsigned char*)lds_;
  const int tid = otid(), lane = tid & 63, wave = tid >> 6;
  const int wm = wave & 1, wn = wave >> 1, r = lane & 31, h = lane >> 5;
  const int lr = lane >> 3, lcp = lane & 7;
  const bf16_t* pa[2]; const bf16_t* pb[4];
#pragma unroll
  for (int i = 0; i < 2; ++i) { const int row = (wave * 2 + i) * 8 + lr; pa[i] = A + (size_t)row * lda + ((lcp ^ ((row >> 1) & 7)) * 8); }
#pragma unroll
  for (int i = 0; i < 4; ++i) { const int row = (wave * 4 + i) * 8 + lr; pb[i] = Bt + (size_t)row * ldb + ((lcp ^ ((row >> 1) & 7)) * 8); }
  f32x16 acc[2][2];
#pragma unroll
  for (int nb = 0; nb < 2; ++nb)
#pragma unroll
    for (int mb = 0; mb < 2; ++mb)
#pragma unroll
      for (int i = 0; i < 16; ++i) acc[nb][mb][i] = 0.f;
  const int x = h ^ ((r >> 1) & 7);
  int co[4];
#pragma unroll
  for (int st = 0; st < 4; ++st) co[st] = (x ^ (2 * st)) << 4;
  const int arow = (wm * 64 + r) * 128;
  const int brow = STG_A + (wn * 64 + r) * 128;
  int pkt = 0; size_t pboff = 0;
  auto issue_part = [&](int sidx, int part) {
    unsigned char* sa = lds + sidx * STG; unsigned char* sb = sa + STG_A;
    if (part == 0) {
#pragma unroll
      for (int i = 0; i < 2; ++i)
        __builtin_amdgcn_global_load_lds((const unsigned*)(pa[i] + pkt * 64), (unsigned*)(sa + (wave * 2 + i) * 1024), 16, 0, 0);
    } else {
#pragma unroll
      for (int i = 2 * (part - 1); i < 2 * part; ++i)
        __builtin_amdgcn_global_load_lds((const unsigned*)(pb[i] + pboff + pkt * 64), (unsigned*)(sb + (wave * 4 + i) * 1024), 16, 0, 0);
    }
  };
  const int nk = K >> 6, total = ntiles * nk;
  const size_t bstep = (size_t)256 * ldb;
  WAIT_VM(0);
  RAW_BARRIER();
  issue_part(0, 0); issue_part(0, 1); issue_part(0, 2);
  if (++pkt == nk) { pkt = 0; pboff += bstep; }
  issue_part(1, 0); issue_part(1, 1); issue_part(1, 2);
  if (++pkt == nk) { pkt = 0; pboff += bstep; }
  int sc = 0, sn = 2, kt = 0, nt = 0;
#pragma unroll 1
  for (int j = 0; j < total; ++j) {
    if (j + 1 < total) WAIT_VM(6); else WAIT_VM(0);
    RAW_BARRIER();
    const bool pre = (j + 2) < total;
    const unsigned char* base = lds + sc * STG;
    bf16x8 fa[2][2], fb[2][2];
    fa[0][0] = *(const bf16x8*)(base + arow + co[0]);
    fa[0][1] = *(const bf16x8*)(base + arow + 4096 + co[0]);
    fb[0][0] = *(const bf16x8*)(base + brow + co[0]);
    fb[0][1] = *(const bf16x8*)(base + brow + 4096 + co[0]);
#pragma unroll
    for (int st = 0; st < 4; ++st) {
      const int cur = st & 1, nxt = cur ^ 1;
      if (st < 3) {
        fa[nxt][0] = *(const bf16x8*)(base + arow + co[st + 1]);
        fa[nxt][1] = *(const bf16x8*)(base + arow + 4096 + co[st + 1]);
        fb[nxt][0] = *(const bf16x8*)(base + brow + co[st + 1]);
        fb[nxt][1] = *(const bf16x8*)(base + brow + 4096 + co[st + 1]);
      }
      asm volatile("" : "+v"(fa[cur][0]), "+v"(fa[cur][1]), "+v"(fb[cur][0]), "+v"(fb[cur][1]) :: "memory");
      acc[0][0] = MFMA(fb[cur][0], fa[cur][0], acc[0][0]);
      acc[0][1] = MFMA(fb[cur][0], fa[cur][1], acc[0][1]);
      acc[1][0] = MFMA(fb[cur][1], fa[cur][0], acc[1][0]);
      acc[1][1] = MFMA(fb[cur][1], fa[cur][1], acc[1][1]);
      if (st < 3 && pre) issue_part(sn, st);
    }
    if (pre) { if (++pkt == nk) { pkt = 0; pboff += bstep; } }
    sc = (sc == 2) ? 0 : sc + 1; sn = (sn == 2) ? 0 : sn + 1;
    if (++kt == nk) {
      RAW_BARRIER();
      epi(acc, nt, lds + sn * STG + wave * EPI_WAVE);
#pragma unroll
      for (int nb = 0; nb < 2; ++nb)
#pragma unroll
        for (int mb = 0; mb < 2; ++mb)
#pragma unroll
          for (int i = 0; i < 16; ++i) acc[nb][mb][i] = 0.f;
      kt = 0; ++nt;
    }
  }
}

template <class Epi>
DI void gemm_merge(const bf16_t* __restrict__ Ht, const unsigned char* segws, const bf16_t* __restrict__ WGj, const bf16_t* __restrict__ WBj, bf16_t* lds_, Epi epi) {
  unsigned char* lds = (unsigned char*)lds_;
  const int tid = otid(), lane = tid & 63, wave = tid >> 6;
  const int wm = wave & 1, wn = wave >> 1, r = lane & 31, h = lane >> 5;
  const int lr = lane >> 3, lcp = lane & 7;
  int oa1[2], oa5[2], ob1[4], ob5[4];
#pragma unroll
  for (int i = 0; i < 2; ++i) { const int row = (wave * 2 + i) * 8 + lr; const int cs = (lcp ^ ((row >> 1) & 7)) * 8; oa1[i] = row * 1024 + cs; oa5[i] = row * 512 + cs; }
#pragma unroll
  for (int i = 0; i < 4; ++i) { const int row = (wave * 4 + i) * 8 + lr; const int cs = (lcp ^ ((row >> 1) & 7)) * 8; ob1[i] = row * 1024 + cs; ob5[i] = row * 512 + cs; }
  f32x16 acc[2][2];
#pragma unroll
  for (int nb = 0; nb < 2; ++nb)
#pragma unroll
    for (int mb = 0; mb < 2; ++mb)
#pragma unroll
      for (int i = 0; i < 16; ++i) acc[nb][mb][i] = 0.f;
  const int x = h ^ ((r >> 1) & 7);
  int co[4];
#pragma unroll
  for (int st = 0; st < 4; ++st) co[st] = (x ^ (2 * st)) << 4;
  const int arow = (wm * 64 + r) * 128;
  const int brow = STG_A + (wn * 64 + r) * 128;
  int pseg = 0, pkt = 0;
  auto issue_part = [&](int sidx, int part) {
    unsigned char* sa = lds + sidx * STG; unsigned char* sb = sa + STG_A;
    const int n = pseg >> 1; const bool gate = (pseg & 1) == 0;
    if (part == 0) {
      const size_t offy = (n == 0) ? OFF_QA : (n == 1) ? OFF_QB : OFF_QCN;
      const bf16_t* ab = gate ? Ht : (const bf16_t*)(segws + offy);
#pragma unroll
      for (int i = 0; i < 2; ++i)
        __builtin_amdgcn_global_load_lds((const unsigned*)(ab + (gate ? oa1[i] : oa5[i]) + pkt * 64), (unsigned*)(sa + (wave * 2 + i) * 1024), 16, 0, 0);
    } else {
      const bf16_t* bb = gate ? (WGj + (size_t)n * 1024 * 1024) : (WBj + (size_t)n * 1024 * 512);
#pragma unroll
      for (int i = 2 * (part - 1); i < 2 * part; ++i)
        __builtin_amdgcn_global_load_lds((const unsigned*)(bb + (gate ? ob1[i] : ob5[i]) + pkt * 64), (unsigned*)(sb + (wave * 4 + i) * 1024), 16, 0, 0);
    }
  };
  auto advance = [&]() { if (++pkt == ((pseg & 1) ? 8 : 16)) { pkt = 0; ++pseg; } };
  constexpr int total = 3 * (16 + 8);
  WAIT_VM(0);
  RAW_BARRIER();
  issue_part(0, 0); issue_part(0, 1); issue_part(0, 2); advance();
  issue_part(1, 0); issue_part(1, 1); issue_part(1, 2); advance();
  int sc = 0, sn = 2, kt = 0, cseg = 0;
#pragma unroll 1
  for (int j = 0; j < total; ++j) {
    if (j + 1 < total) WAIT_VM(6); else WAIT_VM(0);
    RAW_BARRIER();
    const bool pre = (j + 2) < total;
    const unsigned char* base = lds + sc * STG;
    bf16x8 fa[2][2], fb[2][2];
    fa[0][0] = *(const bf16x8*)(base + arow + co[0]);
    fa[0][1] = *(const bf16x8*)(base + arow + 4096 + co[0]);
    fb[0][0] = *(const bf16x8*)(base + brow + co[0]);
    fb[0][1] = *(const bf16x8*)(base + brow + 4096 + co[0]);
#pragma unroll
    for (int st = 0; st < 4; ++st) {
      const int cur = st & 1, nxt = cur ^ 1;
      if (st < 3) {
        fa[nxt][0] = *(const bf16x8*)(base + arow + co[st + 1]);
        fa[nxt][1] = *(const bf16x8*)(base + arow + 4096 + co[st + 1]);
        fb[nxt][0] = *(const bf16x8*)(base + brow + co[st + 1]);
        fb[nxt][1] = *(const bf16x8*)(base + brow + 4096 + co[st + 1]);
      }
      asm volatile("" : "+v"(fa[cur][0]), "+v"(fa[cur][1]), "+v"(fb[cur][0]), "+v"(fb[cur][1]) :: "memory");
      acc[0][0] = MFMA(fb[cur][0], fa[cur][0], acc[0][0]);
      acc[0][1] = MFMA(fb[cur][0], fa[cur][1], acc[0][1]);
      acc[1][0] = MFMA(fb[cur][1], fa[cur][0], acc[1][0]);
      acc[1][1] = MFMA(fb[cur][1], fa[cur][1], acc[1][1]);
      if (st < 3 && pre) issue_part(sn, st);
    }
    if (pre) advance();
    sc = (sc == 2) ? 0 : sc + 1; sn = (sn == 2) ? 0 : sn + 1;
    if (++kt == ((cseg & 1) ? 8 : 16)) {
      epi(acc, cseg);
#pragma unroll
      for (int nb = 0; nb < 2; ++nb)
#pragma unroll
        for (int mb = 0; mb < 2; ++mb)
#pragma unroll
          for (int i = 0; i < 16; ++i) acc[nb][mb][i] = 0.f;
      kt = 0; ++cseg;
    }
  }
}

DI void rot32(const f32x16& v, const float* mul, float sc, const float2* __restrict__ tab, int h, float* o) {
#pragma unroll
  for (int i = 0; i < 8; ++i) {
    const int j = crow(i, h);
    const float2 cs = tab[j];
    const float x1 = v[i] * sc * (mul ? mul[j] : 1.f), x2 = v[i + 8] * sc * (mul ? mul[j + 16] : 1.f);
    o[i] = x1 * cs.x - x2 * cs.y;
    o[i + 8] = x2 * cs.x + x1 * cs.y;
  }
}

struct WS {
  bf16_t *QA, *KA, *VAT, *QB, *KB, *VBT, *QCN, *QCR, *KCN, *KR, *VCT, *H, *T2;
  bf16_t *WP1, *WUQ, *WUKV, *WG, *WB, *WO, *W1, *W2;
  float2 *TABC, *TABB; float* LAM;
};
DI WS make_ws(unsigned char* ws) {
  WS w;
  w.QA = (bf16_t*)(ws + OFF_QA); w.KA = (bf16_t*)(ws + OFF_KA); w.VAT = (bf16_t*)(ws + OFF_VAT);
  w.QB = (bf16_t*)(ws + OFF_QB); w.KB = (bf16_t*)(ws + OFF_KB); w.VBT = (bf16_t*)(ws + OFF_VBT);
  w.QCN = (bf16_t*)(ws + OFF_QCN); w.QCR = (bf16_t*)(ws + OFF_QCR); w.KCN = (bf16_t*)(ws + OFF_KCN);
  w.KR = (bf16_t*)(ws + OFF_KR); w.VCT = (bf16_t*)(ws + OFF_VCT); w.H = (bf16_t*)(ws + OFF_H); w.T2 = (bf16_t*)(ws + OFF_T2);
  w.WP1 = (bf16_t*)(ws + OFF_WP1); w.WUQ = (bf16_t*)(ws + OFF_WUQ); w.WUKV = (bf16_t*)(ws + OFF_WUKV);
  w.WG = (bf16_t*)(ws + OFF_WG); w.WB = (bf16_t*)(ws + OFF_WB); w.WO = (bf16_t*)(ws + OFF_WO);
  w.W1 = (bf16_t*)(ws + OFF_W1); w.W2 = (bf16_t*)(ws + OFF_W2);
  w.TABC = (float2*)(ws + OFF_TABC); w.TABB = (float2*)(ws + OFF_TABB); w.LAM = (float*)(ws + OFF_LAM);
  return w;
}

DI void p1_epi(f32x16 (&acc)[2][2], int ntile, int tok0, const WS& w, const float* __restrict__ aqg, const float* __restrict__ akg, bf16_t* CQ, bf16_t* CKV, unsigned char* sl, float* ssq) {
  const int tid_ = otid();
  const int lane = tid_ & 63, wave = tid_ >> 6;
  const int wm = wave & 1, wn = wave >> 1, r = lane & 31, h = lane >> 5;
  const int c64 = ntile * 256 + wn * 64;
  if (c64 >= NP1) return;
#pragma unroll
  for (int mb = 0; mb < 2; ++mb) {
    const int tl = wm * 64 + mb * 32 + r;
    const int t = tok0 + tl;
    const int s = t & (SEQ - 1), b = t >> 11;
    float oc[2][16];
    if (c64 < 640) {
      const bool isq = c64 < 512;
      const float* g = isq ? aqg : akg;
      float ss = 0.f;
#pragma unroll
      for (int nb = 0; nb < 2; ++nb)
#pragma unroll
        for (int i = 0; i < 16; ++i) ss += acc[nb][mb][i] * acc[nb][mb][i];
      ss = xh_sum(ss);
      const float rs = rsqrtf(ss * (1.f / 64.f) + EPS) * (isq ? 0.125f * LOG2E : 1.f);
      const int t0 = tok0 + wm * 64 + mb * 32;
      bf16_t* dst0 = isq ? (w.QA + (size_t)t0 * 512 + c64) : (w.KA + (size_t)t0 * 128 + (c64 - 512));
      float o2[2][16];
#pragma unroll
      for (int nb = 0; nb < 2; ++nb) {
        const int pos = (nb == 0) ? (s >> 6) : (s & 63);
        rot32(acc[nb][mb], g + nb * 32, rs, w.TABC + pos * 16, h, o2[nb]);
      }
      wave_rows_bf16(sl, o2, dst0, isq ? 512 : 128, lane);
    } else if (c64 < 768) {
      const int kvh = (c64 - 640) >> 6;
#pragma unroll
      for (int nb = 0; nb < 2; ++nb)
        store16T(w.VAT + ((size_t)(b * 2 + kvh) * 64 + nb * 32) * SEQ + vperm(s), acc[nb][mb], 1.f, h);
    } else if (c64 < 1792) {
      const bool isq = c64 < 1280;
      const float sc = isq ? 0.17677669529663687f * LOG2E : 1.f;
      const int t0 = tok0 + wm * 64 + mb * 32;
      bf16_t* dst0 = isq ? (w.QB + (size_t)t0 * 512 + (c64 - 768)) : (w.KB + (size_t)t0 * 512 + (c64 - 1280));
      float o2[2][16];
#pragma unroll
      for (int nb = 0; nb < 2; ++nb) {
#pragma unroll
        for (int i = 0; i < 16; ++i) o2[nb][i] = acc[nb][mb][i] * sc;
#pragma unroll
        for (int i = 0; i < 4; ++i) {
          const float other = xh_other(o2[nb][i], h);
          const float2 cs = w.TABB[s * 4 + i];
          o2[nb][i] = h ? (o2[nb][i] * cs.x + other * cs.y) : (o2[nb][i] * cs.x - other * cs.y);
        }
      }
      wave_rows_bf16(sl, o2, dst0, 512, lane);
    } else if (c64 < 2304) {
      const int hd = (c64 - 1792) >> 6;
#pragma unroll
      for (int nb = 0; nb < 2; ++nb)
        store16T(w.VBT + ((size_t)(b * 8 + hd) * 64 + nb * 32) * SEQ + vperm(s), acc[nb][mb], 1.f, h);
    } else if (c64 < 2688) {
#pragma unroll
      for (int nb = 0; nb < 2; ++nb)
#pragma unroll
        for (int i = 0; i < 16; ++i) oc[nb][i] = acc[nb][mb][i];
      {
        float ss = 0.f;
#pragma unroll
        for (int nb = 0; nb < 2; ++nb)
#pragma unroll
          for (int i = 0; i < 16; ++i) ss += oc[nb][i] * oc[nb][i];
        ss = xh_sum(ss);
        if (h == 0) ssq[((c64 - 2304) >> 6) * 128 + tl] = ss;
      }
      wave_rows_bf16(sl, oc, CQ + (size_t)(wm * 64 + mb * 32) * 384 + (c64 - 2304), 384, lane);
    } else if (c64 < 2944) {
#pragma unroll
      for (int nb = 0; nb < 2; ++nb)
#pragma unroll
        for (int i = 0; i < 16; ++i) oc[nb][i] = acc[nb][mb][i];
      {
        float ss = 0.f;
#pragma unroll
        for (int nb = 0; nb < 2; ++nb)
#pragma unroll
          for (int i = 0; i < 16; ++i) ss += oc[nb][i] * oc[nb][i];
        ss = xh_sum(ss);
        if (h == 0) ssq[(6 + ((c64 - 2688) >> 6)) * 128 + tl] = ss;
      }
      wave_rows_bf16(sl, oc, CKV + (size_t)(wm * 64 + mb * 32) * 256 + (c64 - 2688), 256, lane);
    } else {
      float o[16];
      rot32(acc[0][mb], nullptr, 1.f, w.TABC + s * 16, h, o);
      store16(w.KR + (size_t)t * 32, o, h);
    }
  }
}

template <int DQK>
DI void flash(const bf16x8* qf, const bf16_t* __restrict__ K1, int ld1, const bf16_t* __restrict__ K2, int ld2,
              const bf16_t* __restrict__ Vt, bf16_t* lds, f32x16 (&ot)[2], float& lsum) {
  constexpr int KROW = DQK + 8, CPR = DQK / 8, NCH = 64 * CPR, NS = DQK / 16;
  const int tid = otid(), lane = tid & 63;
  const int r = lane & 31, h = lane >> 5;
  const int id0 = tid, id1 = tid + 512;
  const bool v0 = id0 < NCH, v1 = id1 < NCH;
  const int row0 = id0 / CPR, c0 = id0 % CPR, row1 = id1 / CPR, c1 = id1 % CPR;
  const bf16_t* kp0; size_t ks0;
  const bf16_t* kp1; size_t ks1;
  if (DQK == 96 && c0 >= 8) { kp0 = K2 + (size_t)row0 * ld2 + (c0 - 8) * 8; ks0 = (size_t)64 * ld2; }
  else { kp0 = K1 + (size_t)row0 * ld1 + c0 * 8; ks0 = (size_t)64 * ld1; }
  if (DQK == 96 && c1 >= 8) { kp1 = K2 + (size_t)row1 * ld2 + (c1 - 8) * 8; ks1 = (size_t)64 * ld2; }
  else { kp1 = K1 + (size_t)row1 * ld1 + c1 * 8; ks1 = (size_t)64 * ld1; }
  const int lk0 = row0 * KROW + c0 * 8, lk1 = row1 * KROW + c1 * 8;
  const int vd = tid >> 3, vc = (tid & 7) * 8;
  const bf16_t* vp = Vt + (size_t)vd * SEQ + vc;
  const int lv = vd * VROW + vc;
#pragma unroll
  for (int db = 0; db < 2; ++db)
#pragma unroll
    for (int i = 0; i < 16; ++i) ot[db][i] = 0.f;
  f32x16 NM;
#pragma unroll
  for (int i = 0; i < 16; ++i) NM[i] = 0.f;
  float lacc = 0.f;
  uint4 rk0 = {0, 0, 0, 0}, rk1 = {0, 0, 0, 0}, rv;
  __syncthreads();
  if (v0) rk0 = *(const uint4*)kp0;
  if (v1) rk1 = *(const uint4*)kp1;
  rv = *(const uint4*)vp;
  {
    bf16_t* sk = lds; bf16_t* sv = lds + KST;
    if (v0) *(uint4*)(sk + lk0) = rk0;
    if (v1) *(uint4*)(sk + lk1) = rk1;
    *(uint4*)(sv + lv) = rv;
  }
  __syncthreads();
  constexpr int NTILE = SEQ / 64;
#pragma unroll 1
  for (int kt = 0; kt < NTILE; ++kt) {
    const bf16_t* sk = lds + (kt & 1) * AT_STAGE; const bf16_t* sv = sk + KST;
    const bool more = (kt + 1) < NTILE;
    if (more) {
      if (v0) rk0 = *(const uint4*)(kp0 + (size_t)(kt + 1) * ks0);
      if (v1) rk1 = *(const uint4*)(kp1 + (size_t)(kt + 1) * ks1);
      rv = *(const uint4*)(vp + (kt + 1) * 64);
    }
    f32x16 st[2];
    bf16x8 kf[2][NS];
#pragma unroll
    for (int kb = 0; kb < 2; ++kb)
#pragma unroll
      for (int s = 0; s < NS; ++s) kf[kb][s] = *(const bf16x8*)(sk + (kb * 32 + r) * KROW + s * 16 + h * 8);
    __builtin_amdgcn_sched_barrier(0);
#pragma unroll
    for (int s = 0; s < NS; ++s)
#pragma unroll
      for (int kb = 0; kb < 2; ++kb) st[kb] = MFMA(kf[kb][s], qf[s], (s == 0) ? NM : st[kb]);
    bf16x8 vfr[2][2][2];
#pragma unroll
    for (int kb = 0; kb < 2; ++kb)
#pragma unroll
      for (int s = 0; s < 2; ++s)
#pragma unroll
        for (int db = 0; db < 2; ++db) vfr[kb][s][db] = *(const bf16x8*)(sv + (db * 32 + r) * VROW + kb * 32 + 16 * s + 8 * h);
    __builtin_amdgcn_sched_barrier(0);
    float mx = st[0][0];
#pragma unroll
    for (int i = 1; i < 16; ++i) mx = fmaxf(mx, st[0][i]);
#pragma unroll
    for (int i = 0; i < 16; ++i) mx = fmaxf(mx, st[1][i]);
    mx = xh_max(mx);
    if (kt == 0 || __any(mx > 8.f)) {
      const float d = (kt == 0) ? mx : fmaxf(mx, 0.f);
      const float alpha = ex2(-d);
#pragma unroll
      for (int kb = 0; kb < 2; ++kb)
#pragma unroll
        for (int i = 0; i < 16; ++i) st[kb][i] -= d;
#pragma unroll
      for (int i = 0; i < 16; ++i) NM[i] -= d;
      if (kt != 0) {
#pragma unroll
        for (int db = 0; db < 2; ++db)
#pragma unroll
          for (int i = 0; i < 16; ++i) ot[db][i] *= alpha;
        lacc *= alpha;
      }
    }
#pragma unroll
    for (int kb = 0; kb < 2; ++kb)
#pragma unroll
      for (int s = 0; s < 2; ++s) {
        typedef __attribute__((ext_vector_type(4))) unsigned u32x4;
        u32x4 pp;
#pragma unroll
        for (int e = 0; e < 4; ++e) {
          const float p0 = ex2(st[kb][8 * s + 2 * e]), p1 = ex2(st[kb][8 * s + 2 * e + 1]);
          lacc += p0 + p1;
          pp[e] = pk2(p0, p1);
        }
        const bf16x8 pf = __builtin_bit_cast(bf16x8, pp);
#pragma unroll
        for (int db = 0; db < 2; ++db) ot[db] = MFMA(vfr[kb][s][db], pf, ot[db]);
      }
    if (more) {
      bf16_t* nk_ = lds + ((kt + 1) & 1) * AT_STAGE; bf16_t* nv = nk_ + KST;
      if (v0) *(uint4*)(nk_ + lk0) = rk0;
      if (v1) *(uint4*)(nk_ + lk1) = rk1;
      *(uint4*)(nv + lv) = rv;
    }
    __syncthreads();
  }
  const float l = lacc;
  lsum = xh_sum(l);
}

DI void flash_b(const bf16x8* qf, const bf16_t* __restrict__ K1, int ld1, const bf16_t* __restrict__ Vt, bf16_t* lds,
                f32x16 (&ot)[2][2], float (&lsum)[2]) {
  constexpr int KROW = 72;
  const int tid = otid(), lane = tid & 63;
  const int r = lane & 31, h = lane >> 5;
  const int row0 = tid >> 3, c0 = tid & 7;
  const bf16_t* kp0 = K1 + (size_t)row0 * ld1 + c0 * 8; const size_t ks0 = (size_t)64 * ld1;
  const int lk0 = row0 * KROW + c0 * 8;
  const int vd = tid >> 3, vc = (tid & 7) * 8;
  const bf16_t* vp = Vt + (size_t)vd * SEQ + vc;
  const int lv = vd * VROW + vc;
  f32x16 NM[2];
  float lacc[2] = {0.f, 0.f};
#pragma unroll
  for (int c = 0; c < 2; ++c) {
#pragma unroll
    for (int i = 0; i < 16; ++i) { NM[c][i] = 0.f; ot[c][0][i] = 0.f; ot[c][1][i] = 0.f; }
  }
  uint4 rk0, rv;
  __syncthreads();
  rk0 = *(const uint4*)kp0;
  rv = *(const uint4*)vp;
  *(uint4*)(lds + lk0) = rk0;
  *(uint4*)(lds + KST + lv) = rv;
  __syncthreads();
  constexpr int NTILE = SEQ / 64;
#pragma unroll 1
  for (int kt = 0; kt < NTILE; ++kt) {
    const bf16_t* sk = lds + (kt & 1) * AT_STAGE; const bf16_t* sv = sk + KST;
    const bool more = (kt + 1) < NTILE;
    if (more) { rk0 = *(const uint4*)(kp0 + (size_t)(kt + 1) * ks0); rv = *(const uint4*)(vp + (kt + 1) * 64); }
    bf16x8 vfr[2][2][2];
#pragma unroll
    for (int kb = 0; kb < 2; ++kb)
#pragma unroll
      for (int s = 0; s < 2; ++s)
#pragma unroll
        for (int db = 0; db < 2; ++db) vfr[kb][s][db] = *(const bf16x8*)(sv + (db * 32 + r) * VROW + kb * 32 + 16 * s + 8 * h);
    __builtin_amdgcn_sched_barrier(0);
#pragma unroll
    for (int c = 0; c < 2; ++c) {
      f32x16 st[2];
      bf16x8 kf[2][2];
#pragma unroll
      for (int kb = 0; kb < 2; ++kb)
#pragma unroll
        for (int s = 0; s < 2; ++s) kf[kb][s] = *(const bf16x8*)(sk + (kb * 32 + r) * KROW + (2 * c + s) * 16 + h * 8);
#pragma unroll
      for (int s = 0; s < 2; ++s)
#pragma unroll
        for (int kb = 0; kb < 2; ++kb) st[kb] = MFMA(kf[kb][s], qf[2 * c + s], (s == 0) ? NM[c] : st[kb]);
      float mx = st[0][0];
#pragma unroll
      for (int i = 1; i < 16; ++i) mx = fmaxf(mx, st[0][i]);
#pragma unroll
      for (int i = 0; i < 16; ++i) mx = fmaxf(mx, st[1][i]);
      mx = xh_max(mx);
      if (kt == 0 || __any(mx > 8.f)) {
        const float d = (kt == 0) ? mx : fmaxf(mx, 0.f);
        const float alpha = ex2(-d);
#pragma unroll
        for (int kb = 0; kb < 2; ++kb)
#pragma unroll
          for (int i = 0; i < 16; ++i) st[kb][i] -= d;
#pragma unroll
        for (int i = 0; i < 16; ++i) NM[c][i] -= d;
        if (kt != 0) {
#pragma unroll
          for (int db = 0; db < 2; ++db)
#pragma unroll
            for (int i = 0; i < 16; ++i) ot[c][db][i] *= alpha;
          lacc[c] *= alpha;
        }
      }
#pragma unroll
      for (int kb = 0; kb < 2; ++kb)
#pragma unroll
        for (int s = 0; s < 2; ++s) {
          typedef __attribute__((ext_vector_type(4))) unsigned u32x4;
          u32x4 pp;
#pragma unroll
          for (int e = 0; e < 4; ++e) {
            const float p0 = ex2(st[kb][8 * s + 2 * e]), p1 = ex2(st[kb][8 * s + 2 * e + 1]);
            lacc[c] += p0 + p1;
            pp[e] = pk2(p0, p1);
          }
          const bf16x8 pf = __builtin_bit_cast(bf16x8, pp);
#pragma unroll
          for (int db = 0; db < 2; ++db) ot[c][db] = MFMA(vfr[kb][s][db], pf, ot[c][db]);
        }
    }
    if (more) {
      bf16_t* nk_ = lds + ((kt + 1) & 1) * AT_STAGE;
      *(uint4*)(nk_ + lk0) = rk0;
      *(uint4*)(nk_ + KST + lv) = rv;
    }
    __syncthreads();
  }
#pragma unroll
  for (int c = 0; c < 2; ++c) lsum[c] = xh_sum(lacc[c]);
}

DI bf16x8 ldq(const bf16_t* p) { return *(const bf16x8*)p; }

DI void attn_item(const WS& w, int type, int b, int head, int qt, bf16_t* lds, float lam, float post, const float* __restrict__ subg) {
  const int tid_ = otid();
  const int lane = tid_ & 63, wave = tid_ >> 6;
  const int r = lane & 31, h = lane >> 5;
  const int t = b * SEQ + qt * 256 + wave * 32 + r;
  f32x16 ot[2]; float l;
  if (type == 2) {
    const int kvh = head >> 2;
    bf16_t* qrow = w.QA + (size_t)t * 512 + head * 64;
    bf16x8 qf[4];
#pragma unroll
    for (int s = 0; s < 4; ++s) qf[s] = ldq(qrow + s * 16 + h * 8);
    flash<64>(qf, w.KA + (size_t)b * SEQ * 128 + kvh * 64, 128, nullptr, 0, w.VAT + (size_t)(b * 2 + kvh) * 64 * SEQ, lds, ot, l);
    const float inv = 1.f / l;
    float o2[2][16];
#pragma unroll
    for (int db = 0; db < 2; ++db)
#pragma unroll
      for (int i = 0; i < 16; ++i) o2[db][i] = ot[db][i] * inv;
    wave_rows_bf16((unsigned char*)lds + wave * EPI_WAVE, o2, w.QA + (size_t)(t - r) * 512 + head * 64, 512, lane);
  } else if (type == 1) {
    bf16_t* qrow = w.QCN + (size_t)t * 512 + head * 64;
    const bf16_t* qr2 = w.QCR + (size_t)t * 256 + head * 32;
    bf16x8 qf[6];
#pragma unroll
    for (int s = 0; s < 4; ++s) qf[s] = ldq(qrow + s * 16 + h * 8);
#pragma unroll
    for (int s = 0; s < 2; ++s) qf[4 + s] = ldq(qr2 + s * 16 + h * 8);
    flash<96>(qf, w.KCN + (size_t)b * SEQ * 512 + head * 64, 512, w.KR + (size_t)b * SEQ * 32, 32, w.VCT + (size_t)(b * 8 + head) * 64 * SEQ, lds, ot, l);
    const float inv = 1.f / l;
    float o2[2][16];
#pragma unroll
    for (int db = 0; db < 2; ++db)
#pragma unroll
      for (int i = 0; i < 16; ++i) o2[db][i] = ot[db][i] * inv;
    wave_rows_bf16((unsigned char*)lds + wave * EPI_WAVE, o2, w.QCN + (size_t)(t - r) * 512 + head * 64, 512, lane);
  } else {
    bf16_t* qrow = w.QB + (size_t)t * 512 + head * 64;
    bf16x8 qfb[4];
#pragma unroll
    for (int s = 0; s < 2; ++s) { qfb[s] = ldq(qrow + s * 16 + h * 8); qfb[2 + s] = ldq(qrow + 32 + s * 16 + h * 8); }
    const bf16_t* kb = w.KB + (size_t)b * SEQ * 512 + head * 64;
    const bf16_t* vt = w.VBT + (size_t)(b * 8 + head) * 64 * SEQ;
    f32x16 ob[2][2]; float lb[2];
    flash_b(qfb, kb, 512, vt, lds, ob, lb);
    const float i0 = 1.f / lb[0], i1 = lam / lb[1];
    float ss = 0.f;
#pragma unroll
    for (int db = 0; db < 2; ++db)
#pragma unroll
      for (int i = 0; i < 16; ++i) { const float o = i0 * ob[0][db][i] - i1 * ob[1][db][i]; ot[db][i] = o; ss += o * o; }
    ss = xh_sum(ss);
    const float rs = rsqrtf(ss * (1.f / 64.f) + EPS) * post;
    float o2[2][16];
#pragma unroll
    for (int db = 0; db < 2; ++db)
#pragma unroll
      for (int i = 0; i < 16; ++i) o2[db][i] = ot[db][i] * rs * subg[db * 32 + crow(i, h)];
    wave_rows_bf16((unsigned char*)lds + wave * EPI_WAVE, o2, w.QB + (size_t)(t - r) * 512 + head * 64, 512, lane);
  }
}

__global__ void __launch_bounds__(512) fwd_kernel(Params p) {
  extern __shared__ __attribute__((aligned(16))) unsigned char lds_raw[];
  cg::grid_group grid = cg::this_grid();
  bf16_t* lds = (bf16_t*)lds_raw;
  float* ldsf = (float*)lds_raw;
  float* rstd = (float*)(lds_raw + LDS_RSTD_OFF);
  float* ssq = (float*)(lds_raw + LDS_SSQ_OFF);
  const WS w = make_ws(p.ws);
  const int tid = threadIdx.x, lane = tid & 63, wave = tid >> 6;
  const int wm = wave & 1, wn = wave >> 1, r = lane & 31, h = lane >> 5;
  const int G = gridDim.x;

  for (int i = blockIdx.x * 512 + tid; i < 2048 * 16; i += G * 512) {
    const int pos = i >> 4, j = i & 15;
    const float inv = powf(10000.f, -(float)(2 * j) / 32.f);
    const float ang = (float)pos * inv;
    w.TABC[i] = make_float2(cosf(ang), sinf(ang));
  }
  for (int i = blockIdx.x * 512 + tid; i < 2048 * 4; i += G * 512) {
    const int pos = i >> 2, j = i & 3;
    const float inv = powf(500000.f, -(float)(2 * j) / 8.f);
    const float ang = (float)pos * inv;
    w.TABB[i] = make_float2(cosf(ang), sinf(ang));
  }
  if (blockIdx.x == 0 && tid < DEPTH) {
    const float* lf = p.b_lambda + tid * 128;
    float s1 = 0.f, s2 = 0.f;
    for (int i = 0; i < 32; ++i) { s1 += lf[i] * lf[32 + i]; s2 += lf[64 + i] * lf[96 + i]; }
    w.LAM[tid] = expf(s1) - expf(s2) + p.lam_init[tid];
  }
  convert_T(p.w_in, INC, 1024, NP1, w.WP1, 1024, nullptr, ldsf);
  convert_T(p.c_w_uq, 768, 384, 768, w.WUQ, 384, p.c_q_norm, ldsf);
  convert_T(p.c_w_ukv, 1024, 256, 1024, w.WUKV, 256, p.c_kv_norm, ldsf);
  grid.sync();

  for (int layer = 0; layer < DEPTH; ++layer) {
    bf16_t* xb = (bf16_t*)p.out + (size_t)NT * DM;
    for (int tile = blockIdx.x; tile < NT / 128; tile += G) {
      const int tok0 = tile * 128;
      bf16_t* Ht = w.H + (size_t)tok0 * DM;
      bf16_t* CQ = w.T2 + (size_t)tok0 * 2048;
      bf16_t* CKV = CQ + 128 * 384;
      __syncthreads();
      if (layer == 0) rmsnorm_tile<false>(p.x + (size_t)tok0 * DM, p.ln1_g, Ht, nullptr);
      else rmsnorm_tile_b(xb + (size_t)tok0 * DM, p.ln1_g + layer * DM, Ht);
      const float* aqg = p.a_q_norm + layer * 64; const float* akg = p.a_k_norm + layer * 64;
      gemm_multi(Ht, DM, w.WP1, 1024, 1024, 12, lds,
                 [&](f32x16 (&acc)[2][2], int nt, unsigned char* sl) {
          const int t__ = otid(); const int lane = t__ & 63, wave = t__ >> 6, wm = wave & 1, wn = wave >> 1, r = lane & 31, h = lane >> 5; (void)wm; (void)wn; (void)r; (void)h; (void)lane; p1_epi(acc, nt, tok0, w, aqg, akg, CQ, CKV, sl, ssq); });
      __syncthreads();
      if (tid < 256) {
        const int t_ = tid & 127;
        float ssum = 0.f;
        if (tid < 128) { for (int q = 0; q < 6; ++q) ssum += ssq[q * 128 + t_]; rstd[tid] = rsqrtf(ssum * (1.f / 384.f) + EPS); }
        else { for (int q = 0; q < 4; ++q) ssum += ssq[(6 + q) * 128 + t_]; rstd[tid] = rsqrtf(ssum * (1.f / 256.f) + EPS); }
      }
      gemm_multi(CQ, 384, w.WUQ, 384, 384, 3, lds, [&](f32x16 (&acc)[2][2], int nt, unsigned char*) {
          const int t__ = otid(); const int lane = t__ & 63, wave = t__ >> 6, wm = wave & 1, wn = wave >> 1, r = lane & 31, h = lane >> 5; (void)wm; (void)wn; (void)r; (void)h; (void)lane;
#pragma unroll
          for (int nb = 0; nb < 2; ++nb) {
            const int g32 = nt * 8 + wn * 2 + nb, hd = g32 / 3, part = g32 % 3;
#pragma unroll
            for (int mb = 0; mb < 2; ++mb) {
              const int tl = wm * 64 + mb * 32 + r, t = tok0 + tl, s = t & (SEQ - 1);
              const float rs = rstd[tl] * (0.10206207261596577f * LOG2E);
              if (part < 2) store16v(w.QCN + (size_t)t * 512 + hd * 64 + part * 32, acc[nb][mb], rs, h);
              else { float o[16]; rot32(acc[nb][mb], nullptr, rs, w.TABC + s * 16, h, o); store16(w.QCR + (size_t)t * 256 + hd * 32, o, h); }
            }
          }
        });
      gemm_multi(CKV, 256, w.WUKV, 256, 256, 4, lds, [&](f32x16 (&acc)[2][2], int nt, unsigned char*) {
          const int t__ = otid(); const int lane = t__ & 63, wave = t__ >> 6, wm = wave & 1, wn = wave >> 1, r = lane & 31, h = lane >> 5; (void)wm; (void)wn; (void)r; (void)h; (void)lane;
#pragma unroll
          for (int nb = 0; nb < 2; ++nb) {
            const int g32 = nt * 8 + wn * 2 + nb, hd = g32 >> 2, part = g32 & 3;
#pragma unroll
            for (int mb = 0; mb < 2; ++mb) {
              const int tl = wm * 64 + mb * 32 + r, t = tok0 + tl, s = t & (SEQ - 1), b = t >> 11;
              const float rs = rstd[128 + tl];
              if (part < 2) store16v(w.KCN + (size_t)t * 512 + hd * 64 + part * 32, acc[nb][mb], rs, h);
              else store16T(w.VCT + ((size_t)(b * 8 + hd) * 64 + (part - 2) * 32) * SEQ + vperm(s), acc[nb][mb], rs, h);
            }
          }
        });
    }
    grid.sync();

    {
      const float* win = p.w_in + (size_t)layer * 1024 * INC;
      convert_T(win + NP1, INC, 1024, 3072, w.WG, 1024, nullptr, ldsf);
      for (int n = 0; n < 3; ++n)
        convert_T(p.w_branch + (size_t)(layer * 3 + n) * 512 * 1024, 1024, 512, 1024, w.WB + (size_t)n * 1024 * 512, 512, nullptr, ldsf);
      convert_T(p.w_out + (size_t)layer * 1024 * 1024, 1024, 1024, 1024, w.WO, 1024, nullptr, ldsf);
      convert_T(p.w_ff1 + (size_t)layer * 1024 * 4096, 4096, 1024, 4096, w.W1, 1024, nullptr, ldsf);
      convert_T(p.w_ff2 + (size_t)layer * 4096 * 1024, 1024, 4096, 1024, w.W2, 4096, nullptr, ldsf);
      if (layer + 1 < DEPTH) {
        const int l1 = layer + 1;
        convert_T(p.w_in + (size_t)l1 * 1024 * INC, INC, 1024, NP1, w.WP1, 1024, nullptr, ldsf);
        convert_T(p.c_w_uq + (size_t)l1 * 384 * 768, 768, 384, 768, w.WUQ, 384, p.c_q_norm + l1 * 384, ldsf);
        convert_T(p.c_w_ukv + (size_t)l1 * 256 * 1024, 1024, 256, 1024, w.WUKV, 256, p.c_kv_norm + l1 * 256, ldsf);
      }
      const float lam = w.LAM[layer];
      const float post = 1.f - p.lam_init[layer];
      const float* subg = p.b_subln + layer * 64;
      for (int v = blockIdx.x; v < 3072; v += G) {
        const int type = v >> 10, wi = v & 1023;
        const int k = wi >> 8, blk = wi & 255, xc = blk & 7, j = blk >> 3;
        int b, head; const int qt = j & 7;
        if (type == 2) { const int pair = k * 8 + xc; b = pair >> 1; head = (pair & 1) * 4 + (j >> 3); }
        else { const int pair = (k * 8 + xc) * 4 + (j >> 3); b = pair >> 3; head = pair & 7; }
        attn_item(w, type, b, head, qt, lds, lam, post, subg);
      }
    }
    grid.sync();

    for (int tile = blockIdx.x; tile < NT / 128; tile += G) {
      const int tok0 = tile * 128;
      bf16_t* Ht = w.H + (size_t)tok0 * DM;
      bf16_t* MG = w.T2 + (size_t)tok0 * 2048;
      uint4* GT = (uint4*)(w.QCR + (size_t)tok0 * 256);
      bf16_t* xt = xb + (size_t)tok0 * DM;
      const float* xin = p.x + (size_t)tok0 * DM;
      const unsigned char* segw = p.ws + (size_t)tok0 * 1024;
      for (int jt = 0; jt < 4; ++jt) {
        f32x16 mg[2][2];
#pragma unroll
        for (int nb = 0; nb < 2; ++nb)
#pragma unroll
          for (int mb = 0; mb < 2; ++mb)
#pragma unroll
            for (int i = 0; i < 16; ++i) mg[nb][mb][i] = 0.f;
        gemm_merge(Ht, p.ws + (size_t)tok0 * 1024, w.WG + (size_t)jt * 256 * 1024, w.WB + (size_t)jt * 256 * 512, lds, [&](f32x16 (&acc)[2][2], int sg) {
          const int t__ = otid(); const int lane = t__ & 63, wave = t__ >> 6;
          if ((sg & 1) == 0) {
#pragma unroll
            for (int nb = 0; nb < 2; ++nb)
#pragma unroll
              for (int mb = 0; mb < 2; ++mb) {
                unsigned gq[8];
#pragma unroll
                for (int i = 0; i < 8; ++i) {
                  const float g0 = __builtin_amdgcn_rcpf(1.f + ex2(-LOG2E * acc[nb][mb][2 * i]));
                  const float g1 = __builtin_amdgcn_rcpf(1.f + ex2(-LOG2E * acc[nb][mb][2 * i + 1]));
                  gq[i] = pk2(g0, g1);
                }
                uint4* gd = GT + ((wave * 4 + nb * 2 + mb) * 2) * 64 + lane;
                gd[0] = make_uint4(gq[0], gq[1], gq[2], gq[3]); gd[64] = make_uint4(gq[4], gq[5], gq[6], gq[7]);
              }
          } else {
#pragma unroll
            for (int nb = 0; nb < 2; ++nb)
#pragma unroll
              for (int mb = 0; mb < 2; ++mb) {
                const uint4* gd = GT + ((wave * 4 + nb * 2 + mb) * 2) * 64 + lane;
                const uint4 ga_ = gd[0], gb_ = gd[64];
                const unsigned gq[8] = {ga_.x, ga_.y, ga_.z, ga_.w, gb_.x, gb_.y, gb_.z, gb_.w};
#pragma unroll
                for (int i = 0; i < 8; ++i) {
                  mg[nb][mb][2 * i] += bflo(gq[i]) * acc[nb][mb][2 * i];
                  mg[nb][mb][2 * i + 1] += bfhi(gq[i]) * acc[nb][mb][2 * i + 1];
                }
              }
          }
        });
        {
          const int t__ = otid(); const int lane = t__ & 63, wave = t__ >> 6, wm = wave & 1, wn = wave >> 1;
          __syncthreads();
#pragma unroll
          for (int mb = 0; mb < 2; ++mb) {
            float o2[2][16];
#pragma unroll
            for (int nb = 0; nb < 2; ++nb)
#pragma unroll
              for (int i = 0; i < 16; ++i) o2[nb][i] = mg[nb][mb][i];
            wave_rows_bf16(lds_raw + wave * EPI_WAVE, o2, MG + (size_t)(wm * 64 + mb * 32) * DM + jt * 256 + wn * 64, DM, lane);
          }
        }
      }
      gemm_multi(MG, DM, w.WO, 1024, 1024, 4, lds, [&](f32x16 (&acc)[2][2], int jt, unsigned char* sl) {
          const int t__ = otid(); const int lane = t__ & 63, wave = t__ >> 6, wm = wave & 1, wn = wave >> 1, r = lane & 31, h = lane >> 5; (void)wm; (void)wn; (void)r; (void)h; (void)lane;
#pragma unroll
          for (int nb = 0; nb < 2; ++nb)
#pragma unroll
            for (int mb = 0; mb < 2; ++mb) {
              const size_t ro = (size_t)(wm * 64 + mb * 32) * DM + jt * 256 + wn * 64 + nb * 32;
              if (layer == 0) wave_rows_res<1, 0>(sl, acc[nb][mb], xin + ro, xt + ro, 0, lane);
              else wave_rows_res<0, 0>(sl, acc[nb][mb], xt + ro, xt + ro, 0, lane);
            }
        });
      __syncthreads();
      rmsnorm_tile_b(xt, p.ln2_g + layer * DM, Ht);
      for (int c = 0; c < 2; ++c) {
        gemm_multi(Ht, DM, w.W1 + (size_t)(c * 2048) * 1024, 1024, 1024, 8, lds, [&](f32x16 (&acc)[2][2], int jt, unsigned char* sl) {
            const int t__ = otid(); const int lane = t__ & 63, wave = t__ >> 6, wm = wave & 1, wn = wave >> 1;
#pragma unroll
            for (int mb = 0; mb < 2; ++mb) {
              float o2[2][16];
#pragma unroll
              for (int nb = 0; nb < 2; ++nb)
#pragma unroll
                for (int i = 0; i < 16; ++i) { const float v = fmaxf(acc[nb][mb][i], 0.f); o2[nb][i] = v * v; }
              wave_rows_bf16(sl, o2, MG + (size_t)(wm * 64 + mb * 32) * 2048 + jt * 256 + wn * 64, 2048, lane);
            }
          });
        gemm_multi(MG, 2048, w.W2 + c * 2048, 4096, 2048, 4, lds, [&](f32x16 (&acc)[2][2], int jt, unsigned char* sl) {
            const int t__ = otid(); const int lane = t__ & 63, wave = t__ >> 6, wm = wave & 1, wn = wave >> 1;
#pragma unroll
            for (int nb = 0; nb < 2; ++nb)
#pragma unroll
              for (int mb = 0; mb < 2; ++mb) {
                const size_t ro = (size_t)(wm * 64 + mb * 32) * DM + jt * 256 + wn * 64 + nb * 32;
                if (layer == DEPTH - 1 && c == 1) {
                  const size_t so = (jt == 0) ? OFF_QA : (jt == 1) ? OFF_QB : (jt == 2) ? OFF_KB : OFF_QCN;
                  float* d = (float*)(segw + so) + (size_t)(wm * 64 + mb * 32) * 256 + wn * 64 + nb * 32;
                  wave_rows_res<0, 1>(sl, acc[nb][mb], xt + ro, d, 256, lane);
                } else wave_rows_res<0, 0>(sl, acc[nb][mb], xt + ro, xt + ro, 0, lane);
              }
          });
      }
    }
  }
  grid.sync();
  for (int tile = blockIdx.x; tile < NT / 128; tile += G) {
    const int tok0 = tile * 128;
    final_norm(p.ws + (size_t)tok0 * 1024, p.final_g, p.out + (size_t)tok0 * DM);
  }
}

extern "C" void kernel_launch(void* const* d_in, const int* in_sizes, int n_in, void* d_out, int out_size, void* d_ws, size_t ws_size,
                              hipStream_t stream) {
  static int grid_blocks = 0;
  if (!grid_blocks) {
    int dev = 0, cus = 0, per_cu = 0;
    hipGetDevice(&dev);
    hipDeviceGetAttribute(&cus, hipDeviceAttributeMultiprocessorCount, dev);
    hipFuncSetAttribute((const void*)fwd_kernel, hipFuncAttributeMaxDynamicSharedMemorySize, LDS_BYTES);
    hipOccupancyMaxActiveBlocksPerMultiprocessor(&per_cu, (const void*)fwd_kernel, 512, LDS_BYTES);
    if (per_cu < 1) per_cu = 1;
    grid_blocks = cus * per_cu;
    if (grid_blocks > 256) grid_blocks = 256;
    if (ws_size < WS_END) fprintf(stderr, "workspace too small: %zu < %zu\n", ws_size, (size_t)WS_END);
  }
  Params p{};
  p.x = (const float*)d_in[0]; p.ln1_g = (const float*)d_in[1]; p.w_in = (const float*)d_in[2];
  p.a_q_norm = (const float*)d_in[3]; p.a_k_norm = (const float*)d_in[4]; p.b_lambda = (const float*)d_in[5];
  p.b_subln = (const float*)d_in[6]; p.c_q_norm = (const float*)d_in[7]; p.c_kv_norm = (const float*)d_in[8];
  p.c_w_uq = (const float*)d_in[9]; p.c_w_ukv = (const float*)d_in[10]; p.w_branch = (const float*)d_in[11];
  p.w_out = (const float*)d_in[12]; p.ln2_g = (const float*)d_in[13]; p.w_ff1 = (const float*)d_in[14];
  p.w_ff2 = (const float*)d_in[15]; p.final_g = (const float*)d_in[16];
  p.out = (float*)d_out; p.ws = (unsigned char*)d_ws;
  p.lam_init[0] = 0.2f;
  p.lam_init[1] = 0.35550906759f;
  p.lam_init[2] = 0.47071301834f;
  p.lam_init[3] = 0.55605820416f;
  void* args[] = {&p};
  hipError_t e = hipLaunchCooperativeKernel((const void*)fwd_kernel, dim3(grid_blocks), dim3(512), args, LDS_BYTES, stream);
  if (e != hipSuccess) fprintf(stderr, "cooperative launch failed: %s (grid %d)\n", hipGetErrorString(e), grid_blocks);
}
```
